# Optimizing an MI355X kernel written in HIP

```python
import math
import jax, jax.numpy as jnp
from jax import lax
import numpy as np

D_MODEL = 1024
BATCH = 4
SEQ = 8192
DEPTH = 4

BLOCK_Q = 128
EPS = 1e-6
MLA_HEADS = 6
MLA_Q_LORA = 384
MLA_KV_LORA = 256
MLA_NOPE = 64
MLA_ROPE = 32
MLA_V = 64
ROPE_THETA = 10000.0
DSA_HEADS = 5
DSA_DIM = 64
IDX_HEADS = 8
IDX_DIM = 64
DSA_TOPK = 256
SB_HEADS = 5
SB_DIM = 64
REL_BUCKETS = 32
REL_MAX_DIST = 128
D_FF = -(-8 * D_MODEL // (3 * 256)) * 256
PLE_DIM = 256

MIX_WIDTH = MLA_HEADS * MLA_V + DSA_HEADS * DSA_DIM + SB_HEADS * SB_DIM
IN_SPLITS = (MLA_Q_LORA, MLA_KV_LORA, MLA_ROPE,
             DSA_HEADS * DSA_DIM, DSA_DIM, DSA_DIM,
             IDX_HEADS * IDX_DIM, IDX_DIM, IDX_HEADS,
             SB_HEADS * SB_DIM, SB_HEADS * SB_DIM, SB_HEADS * SB_DIM)
D_IN = sum(IN_SPLITS)

kernel_name = "hybrid_mla_dsa_stickbreak_trunk"


def rms_norm(x, g):
    xf = x.astype(jnp.float32)
    y = xf * lax.rsqrt(jnp.mean(xf * xf, axis=-1, keepdims=True) + EPS)
    return (y * g.astype(jnp.float32)).astype(x.dtype)


def apply_rope(x, pos):
    half = x.shape[-1] // 2
    inv = ROPE_THETA ** (-jnp.arange(half, dtype=jnp.float32) / half)
    ang = pos.astype(jnp.float32)[:, None] * inv[None, :]
    cos = jnp.cos(ang)[None, :, None, :].astype(x.dtype)
    sin = jnp.sin(ang)[None, :, None, :].astype(x.dtype)
    x1, x2 = x[..., :half], x[..., half:]
    return jnp.concatenate([x1 * cos - x2 * sin, x1 * sin + x2 * cos], axis=-1)


def t5_bucket(dist):
    max_exact = REL_BUCKETS // 2
    d = jnp.maximum(dist, 1).astype(jnp.float32)
    large = max_exact + (jnp.log(d / max_exact) / math.log(REL_MAX_DIST / max_exact)
                         * (REL_BUCKETS - max_exact)).astype(jnp.int32)
    large = jnp.minimum(large, REL_BUCKETS - 1)
    return jnp.where(dist < max_exact, dist, large)


def mixer_block(q0, pos, mla_q, mla_k, mla_v, dsa_q, dsa_k, dsa_v,
                idx_q, idx_k, idx_w, sb_q, sb_k, sb_v, rel_bias, topk):
    B = mla_q.shape[0]
    sl = lambda a: lax.dynamic_slice_in_dim(a, q0, BLOCK_Q, axis=1)
    qpos = q0 + jnp.arange(BLOCK_Q, dtype=jnp.int32)
    causal = pos[None, :] <= qpos[:, None]
    strict = pos[None, :] < qpos[:, None]

    s = jnp.einsum('bqhd,bkhd->bhqk', sl(mla_q), mla_k).astype(jnp.float32) * (MLA_NOPE + MLA_ROPE) ** -0.5
    s = jnp.where(causal[None, None], s, -jnp.inf)
    pr = jax.nn.softmax(s, axis=-1).astype(mla_v.dtype)
    o_mla = jnp.einsum('bhqk,bkhd->bqhd', pr, mla_v).reshape(B, BLOCK_Q, MLA_HEADS * MLA_V)

    ilog = jnp.einsum('bqhd,bkd->bqhk', sl(idx_q), idx_k) * IDX_DIM ** -0.5
    isc = jnp.einsum('bqhk,bqh->bqk', jax.nn.relu(ilog), sl(idx_w)).astype(jnp.float32)
    isc = jnp.where(causal[None], isc, -jnp.inf)
    _, sel = lax.top_k(isc, topk)
    valid = sel <= qpos[None, :, None]
    gather = jax.vmap(lambda a, i: a[i])
    kg = gather(dsa_k, sel)
    vg = gather(dsa_v, sel)
    bias = rel_bias[t5_bucket(jnp.maximum(qpos[None, :, None] - sel, 0))]
    a = (jnp.einsum('bqhd,bqjd->bhqj', sl(dsa_q), kg).astype(jnp.float32) * DSA_DIM ** -0.5
         + jnp.transpose(bias, (0, 3, 1, 2)).astype(jnp.float32))
    a = jnp.where(valid[:, None], a, -jnp.inf)
    pa = jax.nn.softmax(a, axis=-1).astype(vg.dtype)
    o_dsa = jnp.einsum('bhqj,bqjd->bqhd', pa, vg).reshape(B, BLOCK_Q, DSA_HEADS * DSA_DIM)

    z = jnp.einsum('bqhd,bkhd->bhqk', sl(sb_q), sb_k).astype(jnp.float32) * SB_DIM ** -0.5
    m = strict[None, None]
    l1m = jnp.where(m, jax.nn.log_sigmoid(-z), 0.0)
    suffix = lax.cumsum(l1m, axis=3, reverse=True) - l1m
    w = jnp.where(m, jnp.exp(jax.nn.log_sigmoid(z) + suffix), 0.0).astype(sb_v.dtype)
    o_sb = jnp.einsum('bhqk,bkhd->bqhd', w, sb_v).reshape(B, BLOCK_Q, SB_HEADS * SB_DIM)

    return jnp.concatenate([o_mla, o_dsa, o_sb], axis=-1)


def setup_inputs(seed: int = 0) -> dict:
    key = jax.random.key(seed)
    ks = jax.random.split(key, 18)
    f32 = jnp.float32
    nrm = lambda k, shape, scale: jax.random.normal(k, shape, f32) * scale
    gain = lambda k, shape: 1.0 + 0.05 * jax.random.normal(k, shape, f32)
    return {
        "x": nrm(ks[0], (BATCH, SEQ, D_MODEL), 1.0),
        "p": nrm(ks[1], (DEPTH, BATCH, SEQ, PLE_DIM), 1.0),
        "w_in": nrm(ks[2], (DEPTH, D_MODEL, D_IN), D_MODEL ** -0.5),
        "attn_norm": gain(ks[3], (DEPTH, D_MODEL)),
        "mla_q_norm": gain(ks[4], (DEPTH, MLA_Q_LORA)),
        "mla_w_uq": nrm(ks[5], (DEPTH, MLA_Q_LORA, MLA_HEADS * (MLA_NOPE + MLA_ROPE)), MLA_Q_LORA ** -0.5),
        "mla_kv_norm": gain(ks[6], (DEPTH, MLA_KV_LORA)),
        "mla_w_ukv": nrm(ks[7], (DEPTH, MLA_KV_LORA, MLA_HEADS * (MLA_NOPE + MLA_V)), MLA_KV_LORA ** -0.5),
        "rel_bias": nrm(ks[8], (REL_BUCKETS, DSA_HEADS), 0.5),
        "w_o": nrm(ks[9], (DEPTH, MIX_WIDTH, D_MODEL), MIX_WIDTH ** -0.5),
        "ffn_norm": gain(ks[10], (DEPTH, D_MODEL)),
        "w_gate": nrm(ks[11], (DEPTH, D_MODEL, D_FF), D_MODEL ** -0.5),
        "w_up": nrm(ks[12], (DEPTH, D_MODEL, D_FF), D_MODEL ** -0.5),
        "w_down": nrm(ks[13], (DEPTH, D_FF, D_MODEL), D_FF ** -0.5),
        "ple_norm": gain(ks[14], (DEPTH, D_MODEL)),
        "w_ple_gate": nrm(ks[15], (DEPTH, D_MODEL, D_MODEL), D_MODEL ** -0.5),
        "w_ple_proj": nrm(ks[16], (DEPTH, PLE_DIM, D_MODEL), PLE_DIM ** -0.5),
        "final_norm": gain(ks[17], (D_MODEL,)),
    }


def reference(x, p, w_in, attn_norm, mla_q_norm, mla_w_uq, mla_kv_norm, mla_w_ukv,
              rel_bias, w_o, ffn_norm, w_gate, w_up, w_down, ple_norm, w_ple_gate,
              w_ple_proj, final_norm):
    B, S, _ = x.shape
    n_blk = S // BLOCK_Q
    topk = min(DSA_TOPK, S // 4)
    pos = jnp.arange(S, dtype=jnp.int32)
    offsets = [int(o) for o in np.cumsum(IN_SPLITS)[:-1]]
    starts = jnp.arange(n_blk, dtype=jnp.int32) * BLOCK_Q
    h = x
    for i in range(DEPTH):
        hn = rms_norm(h, attn_norm[i])
        proj = hn @ w_in[i]
        (c_q, c_kv, k_rope, dq, dk, dv, iq, ik, iw, sq, sk, sv) = jnp.split(proj, offsets, axis=-1)

        q = (rms_norm(c_q, mla_q_norm[i]) @ mla_w_uq[i]).reshape(B, S, MLA_HEADS, MLA_NOPE + MLA_ROPE)
        q = jnp.concatenate([q[..., :MLA_NOPE], apply_rope(q[..., MLA_NOPE:], pos)], axis=-1)
        kv = (rms_norm(c_kv, mla_kv_norm[i]) @ mla_w_ukv[i]).reshape(B, S, MLA_HEADS, MLA_NOPE + MLA_V)
        kr = apply_rope(k_rope[:, :, None, :], pos)
        mla_k = jnp.concatenate([kv[..., :MLA_NOPE],
                                 jnp.broadcast_to(kr, (B, S, MLA_HEADS, MLA_ROPE))], axis=-1)
        mla_v = kv[..., MLA_NOPE:]

        dsa_q = dq.reshape(B, S, DSA_HEADS, DSA_DIM)
        idx_q = iq.reshape(B, S, IDX_HEADS, IDX_DIM)
        idx_w = iw * IDX_HEADS ** -0.5

        sb_q = sq.reshape(B, S, SB_HEADS, SB_DIM)
        sb_k = sk.reshape(B, S, SB_HEADS, SB_DIM)
        sb_v = sv.reshape(B, S, SB_HEADS, SB_DIM)

        blocks = lax.map(lambda q0: mixer_block(q0, pos, q, mla_k, mla_v, dsa_q, dk, dv,
                                                idx_q, ik, idx_w, sb_q, sb_k, sb_v,
                                                rel_bias, topk), starts)
        mix = jnp.transpose(blocks, (1, 0, 2, 3)).reshape(B, S, MIX_WIDTH)
        h = h + mix @ w_o[i]

        hf = rms_norm(h, ffn_norm[i])
        h = h + (jax.nn.silu(hf @ w_gate[i]) * (hf @ w_up[i])) @ w_down[i]

        g = jax.nn.sigmoid(rms_norm(h, ple_norm[i]) @ w_ple_gate[i])
        h = h + g * (p[i] @ w_ple_proj[i])
    return rms_norm(h, final_norm)
```

```cpp
#include <hip/hip_runtime.h>
#include <cstdio>
#include <cstdint>

#ifndef PH
#define PH 0xFFFF
#endif
#ifndef REP_MLA
#define REP_MLA 1
#endif
#ifndef REP_DSA
#define REP_DSA 1
#endif
#ifndef REP_SB
#define REP_SB 1
#endif
#ifndef REP_GEMM
#define REP_GEMM 1
#endif
#ifndef REP_ROW
#define REP_ROW 1
#endif
#ifndef REP_DSEL
#define REP_DSEL 1
#endif
#ifndef REP_DATT
#define REP_DATT 1
#endif
#ifndef PROBE_DRY
#define PROBE_DRY 0
#endif
#ifndef PROBE_BAR
#define PROBE_BAR 0
#endif
#ifndef REP_ATTPH
#define REP_ATTPH 1
#endif
#ifndef REP_INPH
#define REP_INPH 1
#endif
#ifndef REP_PREPPH
#define REP_PREPPH 1
#endif
#ifndef REP_UQPH
#define REP_UQPH 1
#endif
#ifndef REP_GUPH
#define REP_GUPH 1
#endif
#ifndef REP_CONV
#define REP_CONV 1
#endif
#ifndef REP_RANK
#define REP_RANK 1
#endif
#ifndef REP_LIST
#define REP_LIST 1
#endif
#ifndef PROBE_HIST
#define PROBE_HIST 0
#endif
#ifndef PROBE_ZERO
#define PROBE_ZERO 0
#endif

#define LAS __attribute__((address_space(3)))
#define GAS __attribute__((address_space(1)))
typedef unsigned short bf16_t;
typedef short bf16x8 __attribute__((ext_vector_type(8)));
typedef short s16x4 __attribute__((ext_vector_type(4)));
typedef float f32x2 __attribute__((ext_vector_type(2)));
typedef float f32x4 __attribute__((ext_vector_type(4)));
typedef float f32x16 __attribute__((ext_vector_type(16)));
typedef unsigned u32x2 __attribute__((ext_vector_type(2)));
typedef unsigned u32x4 __attribute__((ext_vector_type(4)));
typedef __bf16 bf16x2_t __attribute__((ext_vector_type(2)));

constexpr int SEQ = 8192, NBATCH = 4, M = NBATCH * SEQ, D = 1024, DEPTH = 4, DFF = 2816, PLE = 256, DIN = 2664;
constexpr int NP = 2816;
constexpr float EPS = 1e-6f, LOG2E = 1.4426950408889634f;
constexpr int C_CQ = 0, C_CKV = 384, C_KR = 640, C_IW = 672, C_DQ = 704, C_DK = 1024, C_DV = 1088, C_IQ = 1152, C_IK = 1664, C_SQ = 1728, C_SK = 2048, C_SV = 2368;
constexpr int QM_LD = 576, KV_LD = 768, CQN_LD = 640;
constexpr size_t MiB = 1u << 20;
constexpr size_t WS_CTL = 0, CTL_ZERO_BYTES = 1 * MiB;
constexpr size_t W_IN = 0, W_UQ = 5767168, W_UKV = 6356992, W_O = 6750208, W_GU = 8847360, W_DN = 20381696, W_PG = 26148864, W_PP = 28246016, LAYER_W_BYTES = 28770304;
constexpr size_t WS_W = 1 * MiB;
constexpr size_t WS_HA = 112 * MiB, WS_P = 176 * MiB, WS_QM = 352 * MiB, WS_KV = 388 * MiB, WS_KR = 436 * MiB, WS_CQN = 438 * MiB, WS_SSN = 438 * MiB, WS_IKC = 478 * MiB, WS_DKV = 482 * MiB, WS_PB = 490 * MiB, WS_SS = 506 * MiB, WS_END = 512 * MiB;
constexpr size_t WS_ACT = WS_P, WS_PP = WS_KV;
constexpr size_t SS_BYTES = (size_t)M * 16 * 4;
static_assert(WS_W + DEPTH * LAYER_W_BYTES <= WS_HA && WS_SS + 3 * SS_BYTES <= WS_END, "workspace map");
constexpr int CW_BAR = 4096, CW_Q = 8192, CW_KMAX = 9216;
constexpr int L_H = 0, L_SEL = 131072, L_BIAS = 147456, L_PRM = 151680, L_MISC = 155776, LDS_BYTES = 156160;
constexpr int NWAVES = 8, NTHREADS = 512;

__device__ __forceinline__ unsigned pk_bf16(float lo, float hi) { f32x2 v = {lo, hi}; bf16x2_t b = __builtin_convertvector(v, bf16x2_t); return __builtin_bit_cast(unsigned, b); }
__device__ __forceinline__ float bf_lo(unsigned u) { return __uint_as_float(u << 16); }
__device__ __forceinline__ float bf_hi(unsigned u) { return __uint_as_float(u & 0xffff0000u); }
__device__ __forceinline__ float wave_sum(float v) {
#pragma unroll
    for (int o = 1; o < 64; o <<= 1) v += __shfl_xor(v, o);
    return v;
}
__device__ __forceinline__ void rope_coef(int i, float& c_hi, float& c_lo) { const float c = exp2f(-(float)i * 0.83048202372184f) * 0.15915494309189535f; c_hi = __uint_as_float(__float_as_uint(c) & 0xFFFFE000u); c_lo = c - c_hi; }
__device__ __forceinline__ void rope_sc(float pos, float c_hi, float c_lo, float& sn, float& cs) { const float rev = __builtin_amdgcn_fractf(pos * c_hi) + pos * c_lo; sn = __builtin_amdgcn_sinf(rev); cs = __builtin_amdgcn_cosf(rev); }
__device__ __forceinline__ float relu_i(float x) { return __builtin_bit_cast(float, max(__builtin_bit_cast(int, x), 0)); }
__device__ __forceinline__ int opaque_tid() { int t = threadIdx.x; asm volatile("" : "+v"(t)); return t; }
__device__ __forceinline__ u32x4 opaque_splat(unsigned v) { asm volatile("" : "+v"(v)); return (u32x4){v, v, v, v}; }
__device__ __forceinline__ int crow(int r, int hi) { return (r & 3) + 8 * (r >> 2) + 4 * hi; }
__device__ __forceinline__ f32x16 mfma32(bf16x8 a, bf16x8 b, f32x16 c) { return __builtin_amdgcn_mfma_f32_32x32x16_bf16(a, b, c, 0, 0, 0); }
__device__ __forceinline__ f32x4 mfma16(bf16x8 a, bf16x8 b, f32x4 c) { return __builtin_amdgcn_mfma_f32_16x16x32_bf16(a, b, c, 0, 0, 0); }
typedef short v4i16_t __attribute__((ext_vector_type(4)));
__device__ __forceinline__ s16x4 ldtr(LAS const unsigned char* p) { return __builtin_bit_cast(s16x4, __builtin_amdgcn_ds_read_tr16_b64_v4i16((LAS v4i16_t*)p)); }
__device__ __forceinline__ bf16x8 cat8(s16x4 a, s16x4 b) { return (bf16x8){a[0], a[1], a[2], a[3], b[0], b[1], b[2], b[3]}; }
__device__ __forceinline__ bf16x8 pack8(float a0, float a1, float a2, float a3, float a4, float a5, float a6, float a7) {
    u32x4 w; w.x = pk_bf16(a0, a1); w.y = pk_bf16(a2, a3); w.z = pk_bf16(a4, a5); w.w = pk_bf16(a6, a7); return __builtin_bit_cast(bf16x8, w);
}

namespace pg8 {
constexpr int BM = 256, BK = 64, HALF = 128, HTB = HALF * BK * 2, NXCD = 8, WGM = 8;
__host__ __device__ __forceinline__ int lds_byte(int r, int c) { const int st = (r >> 4) * 2 + (c >> 5), rr = r & 15, cc = c & 31, ob = rr * 64 + cc * 2; return st * 1024 + (ob ^ (((ob >> 9) & 1) << 5)); }
__host__ __device__ __forceinline__ void stage_rc(int b, int& R, int& C) { const int st = b / 1024, sb = b % 1024, swz = sb ^ (((sb >> 9) & 1) << 5); R = (st >> 1) * 16 + swz / 64; C = (st & 1) * 32 + (swz % 64) / 2; }
__host__ __device__ __forceinline__ int perm32(int rho) { const int n = rho >> 4, i = rho & 15; return 8 * (i >> 2) + 4 * n + (i & 3); }
struct Unit { int pm, pn; };
struct Gemm { const bf16_t* A; const bf16_t* Bt; int M, N, K, lda, ldb; };
struct StaticOrder {
    int nM, nN, nwg, G, c;
    __device__ void init(int M_, int N_, int G_, int c_) { nM = M_ / BM; nN = N_ / BM; nwg = nM * nN; G = G_; c = c_; }
    __device__ bool next(int i, Unit& u) const {
        const long L = (long)i * G + c; if (L >= nwg) return false;
        int wgid = (int)L; { const int q = nwg / NXCD, r = nwg % NXCD, xcd = wgid % NXCD, off = wgid / NXCD; wgid = (xcd < r ? xcd * (q + 1) : r * (q + 1) + (xcd - r) * q) + off; }
        const int nig = WGM * nN, gid = wgid / nig, fm = gid * WGM, gsz = (nM - fm) < WGM ? (nM - fm) : WGM;
        u.pm = fm + ((wgid % nig) % gsz); u.pn = (wgid % nig) / gsz; return true;
    }
};

template <class Epi>
__device__ __forceinline__ void gemm_phase(LAS unsigned char* lds, const Gemm g, const StaticOrder& S, const Epi& E) {
    const int tid = opaque_tid(), wid = __builtin_amdgcn_readfirstlane(tid >> 6), lane = tid & 63, wr = wid >> 2, wc = wid & 3, fr = lane & 15, fq = lane >> 4;
    const int K = g.K, nt = K / BK;
    unsigned voffA[2], voffB[2];
#pragma unroll
    for (int i = 0; i < 2; ++i) { int R, C; stage_rc(tid * 16 + i * 8192, R, C); const int Rb = (R & ~31) + perm32(R & 31);
        voffA[i] = (unsigned)(R * g.lda + C) * 2u; voffB[i] = (unsigned)(Rb * g.ldb + C) * 2u; }
    const size_t kstep = (size_t)(BK * 2);
    const size_t hstepA = (size_t)HALF * g.lda * 2, hstepB = (size_t)HALF * g.ldb * 2;
    const size_t tstepA = 2 * hstepA, tstepB = 2 * hstepB;
    const unsigned ldsw = (unsigned)wid * 1024u;
    const int aoff = lds_byte(wr * 64 + fr, fq * 8), boff = lds_byte(wc * 32 + fr, fq * 8);
#define PG8_SA(b, h) (((b) * 2 + (h)) * HTB)
#define PG8_SB(b, h) ((4 + (b) * 2 + (h)) * HTB)
#define PG8_STAGE(bufoff, gbase, voff) do { _Pragma("unroll") for (int _i = 0; _i < 2; ++_i) \
        __builtin_amdgcn_global_load_lds((const unsigned*)((const char*)(gbase) + (voff)[_i]), (LAS unsigned*)(lds + (bufoff) + ldsw + _i * 8192), 16, 0, 0); } while (0)
#define PG8_LDA(dst, b, h) do { _Pragma("unroll") for (int m = 0; m < 4; ++m) _Pragma("unroll") for (int k = 0; k < 2; ++k) dst[m][k] = *(const LAS bf16x8*)(lds + PG8_SA(b, h) + aoff + m * 2048 + k * 1024); } while (0)
#define PG8_LDB(dst, b, h) do { _Pragma("unroll") for (int n = 0; n < 2; ++n) _Pragma("unroll") for (int k = 0; k < 2; ++k) dst[n][k] = *(const LAS bf16x8*)(lds + PG8_SB(b, h) + boff + n * 2048 + k * 1024); } while (0)
#define PG8_MMA(ai, bj, At, Bt) do { __builtin_amdgcn_s_setprio(1); _Pragma("unroll") for (int m = 0; m < 4; ++m) _Pragma("unroll") for (int n = 0; n < 2; ++n) _Pragma("unroll") for (int k = 0; k < 2; ++k) \
        acc[ai][bj][m][n] = __builtin_amdgcn_mfma_f32_16x16x32_bf16(Bt[n][k], At[m][k], acc[ai][bj][m][n], 0, 0, 0); __builtin_amdgcn_s_setprio(0); } while (0)
#define PG8_WAIT_V(n) asm volatile("s_waitcnt vmcnt(" #n ")" ::: "memory")
#define PG8_WAIT_L(n) asm volatile("s_waitcnt lgkmcnt(" #n ")" ::: "memory")
#define PG8_BAR __builtin_amdgcn_s_barrier()
#define PG8_SCHED __builtin_amdgcn_sched_barrier(0)
    Unit cur, nxt; int ui = 0;
    if (!S.next(0, cur)) return;
    f32x4 acc[2][2][4][2];
#pragma unroll
    for (int a = 0; a < 2; ++a)
#pragma unroll
        for (int b = 0; b < 2; ++b)
#pragma unroll
            for (int m = 0; m < 4; ++m)
#pragma unroll
                for (int n = 0; n < 2; ++n) acc[a][b][m][n] = (f32x4){0.f, 0.f, 0.f, 0.f};
    bf16x8 At[4][2], B0[2][2], B1[2][2];
    const char* cA = (const char*)g.A + (size_t)cur.pm * tstepA; const char* cB = (const char*)g.Bt + (size_t)cur.pn * tstepB;
    PG8_STAGE(PG8_SB(0, 0), cB, voffB); PG8_STAGE(PG8_SB(0, 1), cB + hstepB, voffB); PG8_STAGE(PG8_SA(0, 0), cA, voffA); PG8_STAGE(PG8_SA(0, 1), cA + hstepA, voffA);
    if (wr == 1) PG8_BAR;
    PG8_WAIT_V(2); PG8_BAR;
    PG8_STAGE(PG8_SB(1, 0), cB + kstep, voffB); PG8_STAGE(PG8_SA(1, 0), cA + kstep, voffA); PG8_STAGE(PG8_SB(1, 1), cB + hstepB + kstep, voffB);
    PG8_WAIT_V(6); PG8_BAR;
    for (;;) {
        const bool has_next = S.next(ui + 1, nxt);
        const char* nA = has_next ? (const char*)g.A + (size_t)nxt.pm * tstepA : cA; const char* nB = has_next ? (const char*)g.Bt + (size_t)nxt.pn * tstepB : cB;
#pragma unroll 1
        for (int t = 0; t < nt; t += 2) {
            const bool last = (t == nt - 2);
            const char* a1 = cA + (size_t)(t + 1) * kstep;
            const char* a2 = last ? nA : cA + (size_t)(t + 2) * kstep; const char* b2 = last ? nB : cB + (size_t)(t + 2) * kstep;
            const char* a3 = a2 + kstep; const char* b3 = b2 + kstep;
            PG8_LDB(B0, 0, 0); PG8_LDB(B1, 0, 1); PG8_SCHED; PG8_LDA(At, 0, 0); PG8_STAGE(PG8_SA(1, 1), a1 + hstepA, voffA);
            PG8_WAIT_V(8); PG8_WAIT_L(0); PG8_BAR; PG8_MMA(0, 0, At, B0); PG8_MMA(0, 1, At, B1); PG8_BAR; PG8_SCHED;
            PG8_LDA(At, 0, 1); PG8_STAGE(PG8_SB(0, 0), b2, voffB); PG8_STAGE(PG8_SB(0, 1), b2 + hstepB, voffB); PG8_STAGE(PG8_SA(0, 0), a2, voffA);
            PG8_WAIT_V(8); PG8_WAIT_L(0); PG8_BAR; PG8_MMA(1, 0, At, B0); PG8_MMA(1, 1, At, B1); PG8_BAR; PG8_SCHED;
            PG8_LDB(B0, 1, 0); PG8_LDB(B1, 1, 1); PG8_SCHED; PG8_LDA(At, 1, 0); PG8_STAGE(PG8_SA(0, 1), a2 + hstepA, voffA);
            PG8_WAIT_V(8); PG8_WAIT_L(0); PG8_BAR; PG8_MMA(0, 0, At, B0); PG8_MMA(0, 1, At, B1); PG8_BAR; PG8_SCHED;
            PG8_LDA(At, 1, 1); PG8_STAGE(PG8_SB(1, 0), b3, voffB); PG8_STAGE(PG8_SB(1, 1), b3 + hstepB, voffB); PG8_STAGE(PG8_SA(1, 0), a3, voffA);
            PG8_WAIT_V(8); PG8_WAIT_L(0); PG8_BAR; PG8_MMA(1, 0, At, B0); PG8_MMA(1, 1, At, B1); PG8_BAR; PG8_SCHED;
        }
        if (wr == 0) PG8_BAR;
        E(acc, cur, wr, wc, fr, fq);
        if (!has_next) break;
#pragma unroll
        for (int a = 0; a < 2; ++a)
#pragma unroll
            for (int b = 0; b < 2; ++b)
#pragma unroll
                for (int m = 0; m < 4; ++m)
#pragma unroll
                    for (int n = 0; n < 2; ++n) acc[a][b][m][n] = (f32x4){0.f, 0.f, 0.f, 0.f};
        cur = nxt; cA = nA; cB = nB; ++ui;
        if (wr == 1) PG8_BAR;
    }
    PG8_WAIT_V(0);
    PG8_BAR;
#undef PG8_SA
#undef PG8_SB
#undef PG8_STAGE
#undef PG8_LDA
#undef PG8_LDB
#undef PG8_MMA
#undef PG8_WAIT_V
#undef PG8_WAIT_L
#undef PG8_BAR
#undef PG8_SCHED
}

typedef const f32x4 (&AccRef)[2][2][4][2];
__device__ __forceinline__ float row_rstd(const float* ss, int row) {
    const f32x4* p = (const f32x4*)(ss + (size_t)row * 16); const f32x4 a = p[0], b = p[1], c = p[2], d = p[3];
    const float t = ((a[0] + a[1]) + (a[2] + a[3])) + ((b[0] + b[1]) + (b[2] + b[3])) + ((c[0] + c[1]) + (c[2] + c[3])) + ((d[0] + d[1]) + (d[2] + d[3]));
    return rsqrtf(t * (1.f / D) + EPS);
}
constexpr int SSN_LD = 32;
__device__ __forceinline__ float row_rstd_q(const float* ssn, int row) {
    const f32x4* p = (const f32x4*)(ssn + (size_t)row * SSN_LD); const f32x4 a = p[0], b = p[1], c = p[2];
    const float t = ((a[0] + a[1]) + (a[2] + a[3])) + ((b[0] + b[1]) + (b[2] + b[3])) + ((c[0] + c[1]) + (c[2] + c[3]));
    return rsqrtf(t * (1.f / 384.f) + EPS);
}
__device__ __forceinline__ float row_rstd_kv(const float* ssn, int row) {
    const f32x4* p = (const f32x4*)(ssn + (size_t)row * SSN_LD + 12); const f32x4 a = p[0], b = p[1];
    const float t = ((a[0] + a[1]) + (a[2] + a[3])) + ((b[0] + b[1]) + (b[2] + b[3]));
    return rsqrtf(t * (1.f / 256.f) + EPS);
}
template <int MODE>
__device__ __forceinline__ void rstd8(const float* ss, int row0, int fq, float (&rs)[8]) {
    f32x4 p[8];
#pragma unroll
    for (int i = 0; i < 8; ++i) { const int row = row0 + (i >> 2) * HALF + (i & 3) * 16; p[i] = (f32x4){0.f, 0.f, 0.f, 0.f};
        if (MODE == 1) p[i] = *(const f32x4*)(ss + (size_t)row * 16 + 4 * fq);
        else if (MODE == 2) p[i] = *(const f32x4*)(ss + (size_t)row * SSN_LD + 4 * min(fq, 2));
        else p[i] = *(const f32x4*)(ss + (size_t)row * SSN_LD + 12 + 4 * (fq & 1)); }
    __builtin_amdgcn_sched_barrier(0);
#pragma unroll
    for (int i = 0; i < 8; ++i) { float t = (p[i][0] + p[i][1]) + (p[i][2] + p[i][3]); if (MODE == 2) t = (fq < 3) ? t : 0.f; if (MODE == 3) t = (fq < 2) ? t : 0.f;
        t += __shfl_xor(t, 16); t += __shfl_xor(t, 32);
        rs[i] = rsqrtf(t * (MODE == 1 ? 1.f / D : MODE == 2 ? 1.f / 384.f : 1.f / 256.f) + EPS); }
}
struct EpiBf16 {
    bf16_t* O; int ldc; int ncols; const float* ss; int mode;
    __device__ __forceinline__ void operator()(AccRef acc, const Unit& u, int wr, int wc, int fr, int fq) const {
        const int row0 = u.pm * BM + wr * 64 + fr;
        float rs8[8];
        if (mode == 2) rstd8<3>(ss, row0, fq, rs8); else {
#pragma unroll
            for (int i = 0; i < 8; ++i) rs8[i] = 1.f; }
#pragma unroll
        for (int ai = 0; ai < 2; ++ai)
#pragma unroll
            for (int m = 0; m < 4; ++m) { const int row = row0 + ai * HALF + m * 16; const float rs = rs8[4 * ai + m];
#pragma unroll
                for (int bj = 0; bj < 2; ++bj) { const int col0 = u.pn * BM + bj * HALF + wc * 32 + 8 * fq; if (col0 >= ncols) continue;
                    const f32x4 v0 = acc[ai][bj][m][0] * rs, v1 = acc[ai][bj][m][1] * rs;
                    u32x4 w; w.x = pk_bf16(v0[0], v0[1]); w.y = pk_bf16(v0[2], v0[3]); w.z = pk_bf16(v1[0], v1[1]); w.w = pk_bf16(v1[2], v1[3]);
                    *(u32x4*)(O + (size_t)row * ldc + col0) = w; } }
    }
};
struct EpiUq {
    bf16_t* O; const float* ssn;
    __device__ __forceinline__ void operator()(AccRef acc, const Unit& u, int wr, int wc, int fr, int fq) const {
        const int row0 = u.pm * BM + wr * 64 + fr;
        float rs8[8]; rstd8<2>(ssn, row0, fq, rs8);
#pragma unroll
        for (int bj = 0; bj < 2; ++bj) { const int col0 = u.pn * BM + bj * HALF + wc * 32 + 8 * fq; if (col0 >= QM_LD) continue;
            const int w = col0 % 96; const bool rope = w >= 64; const int i0 = (w - 64) >> 1;
            float ch[4], cl[4];
#pragma unroll
            for (int p = 0; p < 4; ++p) rope_coef(i0 + p, ch[p], cl[p]);
#pragma unroll
            for (int ai = 0; ai < 2; ++ai)
#pragma unroll
                for (int m = 0; m < 4; ++m) { const int row = row0 + ai * HALF + m * 16; const float rs = rs8[4 * ai + m]; f32x4 v0 = acc[ai][bj][m][0] * rs, v1 = acc[ai][bj][m][1] * rs;
                    if (rope) { const float pos = (float)(row & (SEQ - 1));
                        float s, c;
                        rope_sc(pos, ch[0], cl[0], s, c); { const float x1 = v0[0], x2 = v0[1]; v0[0] = x1 * c - x2 * s; v0[1] = x1 * s + x2 * c; }
                        rope_sc(pos, ch[1], cl[1], s, c); { const float x1 = v0[2], x2 = v0[3]; v0[2] = x1 * c - x2 * s; v0[3] = x1 * s + x2 * c; }
                        rope_sc(pos, ch[2], cl[2], s, c); { const float x1 = v1[0], x2 = v1[1]; v1[0] = x1 * c - x2 * s; v1[1] = x1 * s + x2 * c; }
                        rope_sc(pos, ch[3], cl[3], s, c); { const float x1 = v1[2], x2 = v1[3]; v1[2] = x1 * c - x2 * s; v1[3] = x1 * s + x2 * c; } }
                    u32x4 wv; wv.x = pk_bf16(v0[0], v0[1]); wv.y = pk_bf16(v0[2], v0[3]); wv.z = pk_bf16(v1[0], v1[1]); wv.w = pk_bf16(v1[2], v1[3]);
                    *(u32x4*)(O + (size_t)row * QM_LD + col0) = wv; } }
    }
};
__device__ __forceinline__ float sq8(const u32x4 w) { return (bf_lo(w.x) * bf_lo(w.x) + bf_hi(w.x) * bf_hi(w.x)) + (bf_lo(w.y) * bf_lo(w.y) + bf_hi(w.y) * bf_hi(w.y)) + (bf_lo(w.z) * bf_lo(w.z) + bf_hi(w.z) * bf_hi(w.z)) + (bf_lo(w.w) * bf_lo(w.w) + bf_hi(w.w) * bf_hi(w.w)); }
struct EpiInProj {
    bf16_t* O; const float* ss; float* SSn; bf16_t* KR; bf16_t* IKC; bf16_t* DKV; unsigned* kmaxw;
    __device__ __forceinline__ void operator()(AccRef acc, const Unit& u, int wr, int wc, int fr, int fq) const {
        const int row0 = u.pm * BM + wr * 64 + fr, slab0 = u.pn * 8 + wc;
        float ch[4], cl[4];
        if (slab0 + 4 == 20) {
#pragma unroll
            for (int p = 0; p < 4; ++p) rope_coef(4 * fq + p, ch[p], cl[p]); }
        float kmx = 0.f;
        float rs8[8]; rstd8<1>(ss, row0, fq, rs8);
#pragma unroll
        for (int ai = 0; ai < 2; ++ai)
#pragma unroll
            for (int m = 0; m < 4; ++m) { const int row = row0 + ai * HALF + m * 16; const float rs = rs8[4 * ai + m];
#pragma unroll
                for (int bj = 0; bj < 2; ++bj) { const int slab = slab0 + 4 * bj, col0 = slab * 32 + 8 * fq; if (slab >= 84) continue;
                    f32x4 v0 = acc[ai][bj][m][0] * rs, v1 = acc[ai][bj][m][1] * rs;
                    u32x4 w; w.x = pk_bf16(v0[0], v0[1]); w.y = pk_bf16(v0[2], v0[3]); w.z = pk_bf16(v1[0], v1[1]); w.w = pk_bf16(v1[2], v1[3]);
                    *(u32x4*)(O + (size_t)row * NP + col0) = w;
                    if (slab < 20) { float sq = sq8(w); sq += __shfl_xor(sq, 16); sq += __shfl_xor(sq, 32); if (fq == 0) SSn[(size_t)row * SSN_LD + slab] = sq; }
                    else if (slab == 20) { const float pos = (float)(row & (SEQ - 1)); float s, c;
                        rope_sc(pos, ch[0], cl[0], s, c); { const float x1 = v0[0], x2 = v0[1]; v0[0] = x1 * c - x2 * s; v0[1] = x1 * s + x2 * c; }
                        rope_sc(pos, ch[1], cl[1], s, c); { const float x1 = v0[2], x2 = v0[3]; v0[2] = x1 * c - x2 * s; v0[3] = x1 * s + x2 * c; }
                        rope_sc(pos, ch[2], cl[2], s, c); { const float x1 = v1[0], x2 = v1[1]; v1[0] = x1 * c - x2 * s; v1[1] = x1 * s + x2 * c; }
                        rope_sc(pos, ch[3], cl[3], s, c); { const float x1 = v1[2], x2 = v1[3]; v1[2] = x1 * c - x2 * s; v1[3] = x1 * s + x2 * c; }
                        u32x4 wk; wk.x = pk_bf16(v0[0], v0[1]); wk.y = pk_bf16(v0[2], v0[3]); wk.z = pk_bf16(v1[0], v1[1]); wk.w = pk_bf16(v1[2], v1[3]);
                        *(u32x4*)(KR + (size_t)row * 32 + 8 * fq) = wk; }
                    else if (slab >= 32 && slab < 36) *(u32x4*)(DKV + (size_t)row * 128 + (slab - 32) * 32 + 8 * fq) = w;
                    else if (slab == 52 || slab == 53) { *(u32x4*)(IKC + (size_t)row * 64 + (slab - 52) * 32 + 8 * fq) = w;
                        float sq = sq8(w); sq += __shfl_xor(sq, 16); sq += __shfl_xor(sq, 32); kmx = fmaxf(kmx, sq); } } }
        if (slab0 + 4 == 52 || slab0 + 4 == 53) {
            kmx = fmaxf(kmx, __shfl_xor(kmx, 1)); kmx = fmaxf(kmx, __shfl_xor(kmx, 2)); kmx = fmaxf(kmx, __shfl_xor(kmx, 4)); kmx = fmaxf(kmx, __shfl_xor(kmx, 8));
            if (fr == 0 && fq == 0) atomicMax(kmaxw + 64 * ((u.pm * BM) / SEQ) + (slab0 + 4 - 52), __float_as_uint(kmx)); }
    }
};
struct EpiResid {
    bf16_t* H; float* SSo;
    __device__ __forceinline__ void operator()(AccRef acc, const Unit& u, int wr, int wc, int fr, int fq) const {
        const int row0 = u.pm * BM + wr * 64 + fr;
#pragma unroll
        for (int ai = 0; ai < 2; ++ai) {
            u32x4 hv[4][2];
#pragma unroll
            for (int m = 0; m < 4; ++m)
#pragma unroll
                for (int bj = 0; bj < 2; ++bj) hv[m][bj] = *(const u32x4*)(H + (size_t)(row0 + ai * HALF + m * 16) * D + u.pn * BM + bj * HALF + wc * 32 + 8 * fq);
            __builtin_amdgcn_sched_barrier(0);
#pragma unroll
            for (int m = 0; m < 4; ++m) { const int row = row0 + ai * HALF + m * 16; const size_t ro = (size_t)row * D; float sq = 0.f;
#pragma unroll
                for (int bj = 0; bj < 2; ++bj) { const int col0 = u.pn * BM + bj * HALF + wc * 32 + 8 * fq;
                    const u32x4 h4 = hv[m][bj]; const f32x4 a0 = acc[ai][bj][m][0], a1 = acc[ai][bj][m][1];
                    u32x4 w; w.x = pk_bf16(bf_lo(h4.x) + a0[0], bf_hi(h4.x) + a0[1]); w.y = pk_bf16(bf_lo(h4.y) + a0[2], bf_hi(h4.y) + a0[3]);
                    w.z = pk_bf16(bf_lo(h4.z) + a1[0], bf_hi(h4.z) + a1[1]); w.w = pk_bf16(bf_lo(h4.w) + a1[2], bf_hi(h4.w) + a1[3]);
                    *(u32x4*)(H + ro + col0) = w; sq += sq8(w); }
                sq += __shfl_xor(sq, 16); sq += __shfl_xor(sq, 32);
                if (fq == 0) SSo[(size_t)row * 16 + u.pn * 4 + wc] = sq; } }
    }
};
struct EpiSwiglu {
    bf16_t* O; const float* ss;
    __device__ __forceinline__ void operator()(AccRef acc, const Unit& u, int wr, int wc, int fr, int fq) const {
        const int row0 = u.pm * BM + wr * 64 + fr; const int col0 = u.pn * HALF + wc * 32 + 8 * fq;
        float rs8[8]; rstd8<1>(ss, row0, fq, rs8);
#pragma unroll
        for (int ai = 0; ai < 2; ++ai)
#pragma unroll
            for (int m = 0; m < 4; ++m) { const int row = row0 + ai * HALF + m * 16; const float rs = rs8[4 * ai + m]; float r[8];
#pragma unroll
                for (int n = 0; n < 2; ++n)
#pragma unroll
                    for (int i = 0; i < 4; ++i) { const float gv = acc[ai][0][m][n][i] * rs, uv = acc[ai][1][m][n][i] * rs;
                        r[4 * n + i] = gv * __builtin_amdgcn_rcpf(1.f + __builtin_amdgcn_exp2f(-gv * LOG2E)) * uv; }
                u32x4 w; w.x = pk_bf16(r[0], r[1]); w.y = pk_bf16(r[2], r[3]); w.z = pk_bf16(r[4], r[5]); w.w = pk_bf16(r[6], r[7]);
                *(u32x4*)(O + (size_t)row * DFF + col0) = w; }
    }
};
struct EpiPle {
    const bf16_t* Hin; bf16_t* Hout; const bf16_t* PPb; const float* ss; float* SSo;
    __device__ __forceinline__ void operator()(AccRef acc, const Unit& u, int wr, int wc, int fr, int fq) const {
        const int row0 = u.pm * BM + wr * 64 + fr;
        float rs8[8]; rstd8<1>(ss, row0, fq, rs8);
#pragma unroll
        for (int ai = 0; ai < 2; ++ai)
#pragma unroll
        for (int mp = 0; mp < 2; ++mp) {
            u32x4 pw[2][2], hv[2][2];
#pragma unroll
            for (int mm = 0; mm < 2; ++mm)
#pragma unroll
                for (int bj = 0; bj < 2; ++bj) { const size_t o_ = (size_t)(row0 + ai * HALF + (2 * mp + mm) * 16) * D + u.pn * BM + bj * HALF + wc * 32 + 8 * fq; pw[mm][bj] = *(const u32x4*)(PPb + o_); hv[mm][bj] = *(const u32x4*)(Hin + o_); }
            __builtin_amdgcn_sched_barrier(0);
#pragma unroll
            for (int mm = 0; mm < 2; ++mm) { const int m = 2 * mp + mm; const int row = row0 + ai * HALF + m * 16; const size_t ro = (size_t)row * D; const float rs = rs8[4 * ai + m]; float sq = 0.f;
#pragma unroll
                for (int bj = 0; bj < 2; ++bj) { const int col0 = u.pn * BM + bj * HALF + wc * 32 + 8 * fq;
                    const u32x4 p4 = pw[mm][bj], h4 = hv[mm][bj];
                    const f32x4 g0 = acc[ai][bj][m][0] * rs, g1 = acc[ai][bj][m][1] * rs;
                    float sg[8];
#pragma unroll
                    for (int i = 0; i < 4; ++i) { sg[i] = __builtin_amdgcn_rcpf(1.f + __builtin_amdgcn_exp2f(-g0[i] * LOG2E)); sg[4 + i] = __builtin_amdgcn_rcpf(1.f + __builtin_amdgcn_exp2f(-g1[i] * LOG2E)); }
                    u32x4 w; w.x = pk_bf16(bf_lo(h4.x) + sg[0] * bf_lo(p4.x), bf_hi(h4.x) + sg[1] * bf_hi(p4.x)); w.y = pk_bf16(bf_lo(h4.y) + sg[2] * bf_lo(p4.y), bf_hi(h4.y) + sg[3] * bf_hi(p4.y));
                    w.z = pk_bf16(bf_lo(h4.z) + sg[4] * bf_lo(p4.z), bf_hi(h4.z) + sg[5] * bf_hi(p4.z)); w.w = pk_bf16(bf_lo(h4.w) + sg[6] * bf_lo(p4.w), bf_hi(h4.w) + sg[7] * bf_hi(p4.w));
                    *(u32x4*)(Hout + ro + col0) = w; sq += sq8(w); }
                sq += __shfl_xor(sq, 16); sq += __shfl_xor(sq, 32);
                if (fq == 0) SSo[(size_t)row * 16 + u.pn * 4 + wc] = sq; } }
    }
};
}

#define XB_TMO      128
#define XB_XCNT(j)  (256  + 64 * (j))
#define XB_XSUB(j)  (1280 + 64 * (j))
#define XB_XGEN(j)  (2304 + 64 * (j))
#define XB_TOP      3328
#define XB_TOPGEN   3392
#define XCD_BAR_WORDS 3456
#define XB_SPIN_CAP (1u << 23)
__device__ __forceinline__ unsigned xb_ld(unsigned* p)              { return __hip_atomic_load(p, __ATOMIC_RELAXED, __HIP_MEMORY_SCOPE_AGENT); }
__device__ __forceinline__ unsigned xb_add(unsigned* p, unsigned v) { return __hip_atomic_fetch_add(p, v, __ATOMIC_RELAXED, __HIP_MEMORY_SCOPE_AGENT); }
__device__ __forceinline__ unsigned xb_xcc_id() { return (unsigned)__builtin_amdgcn_s_getreg((3 << 11) | 20) & 0xFu; }
#define XB_SPIN(cond, bar) do { unsigned _sp = 0; while (cond) { __builtin_amdgcn_s_sleep(1); \
    if ((++_sp & 255u) == 0u) { if (xb_ld(&(bar)[XB_TMO])) break; if (_sp > XB_SPIN_CAP) { atomicAdd(&(bar)[XB_TMO], 1u); break; } } } } while (0)
struct XcdBarrier { unsigned* bar; unsigned x; volatile LAS unsigned* st; };
__device__ __forceinline__ XcdBarrier xcd_barrier_post(unsigned* bar, volatile LAS unsigned* st) {
    XcdBarrier b; b.bar = bar; b.x = xb_xcc_id(); b.st = st;
    if (threadIdx.x == 0) (void)xb_add(&bar[XB_XCNT(b.x)], 1u);
    return b;
}
__device__ __forceinline__ void xcd_barrier_complete(unsigned* bar, unsigned x, unsigned& nloc, unsigned& nx) {
    const unsigned G = gridDim.x * gridDim.y * gridDim.z;
    unsigned sum, cnt, mine, sp = 0u;
    for (;;) {
        sum = 0u; cnt = 0u; mine = 0u;
#pragma unroll
        for (unsigned j = 0; j < 16; ++j) { const unsigned c = xb_ld(&bar[XB_XCNT(j)]); sum += c; cnt += (c > 0u) ? 1u : 0u; mine = (j == x) ? c : mine; }
        if (sum == G) break;
        __builtin_amdgcn_s_sleep(1);
        if ((++sp & 255u) == 0u) { if (xb_ld(&bar[XB_TMO])) break; if (sp > XB_SPIN_CAP) { atomicAdd(&bar[XB_TMO], 1u); break; } }
    }
    nloc = mine > 0u ? mine : 1u; nx = cnt > 0u ? cnt : 1u;
}
__device__ __forceinline__ void xcd_barrier(const XcdBarrier& b) {
    asm volatile("s_waitcnt vmcnt(0)" ::: "memory");
    __syncthreads();
    if (threadIdx.x == 0) {
        unsigned* bar = b.bar; unsigned bx_ = b.x;
        asm volatile("" : "+s"(bar), "+s"(bx_));
        __builtin_amdgcn_s_waitcnt(0);
        unsigned nloc = b.st[0], nx = b.st[1];
        if (nloc == 0u) { xcd_barrier_complete(bar, bx_, nloc, nx); b.st[0] = nloc; b.st[1] = nx; }
        const unsigned old = xb_add(&bar[XB_XSUB(bx_)], 1u);
        const unsigned gen = old / nloc;
        if (old + 1u == (gen + 1u) * nloc) {
            __builtin_amdgcn_fence(__ATOMIC_RELEASE, "agent");
            asm volatile("s_waitcnt vmcnt(0)" ::: "memory");
            const unsigned og = xb_add(&bar[XB_TOP], 1u);
            const unsigned tg = og / nx;
            if (og + 1u == (tg + 1u) * nx) xb_add(&bar[XB_TOPGEN], 1u);
            else XB_SPIN(xb_ld(&bar[XB_TOPGEN]) == tg, bar);
            __builtin_amdgcn_fence(__ATOMIC_ACQUIRE, "agent");
            xb_add(&bar[XB_XGEN(bx_)], 1u);
            asm volatile("s_waitcnt vmcnt(0)" ::: "memory");
        } else {
            XB_SPIN(xb_ld(&bar[XB_XGEN(bx_)]) == gen, bar);
            __builtin_amdgcn_fence(__ATOMIC_ACQUIRE, "agent");
            asm volatile("s_waitcnt vmcnt(0)" ::: "memory");
        }
    }
    __syncthreads();
}

struct MapIn { const float* W;
    __device__ __forceinline__ void operator()(int n, const float*& src, int& ld, float& sc) const {
        ld = DIN; sc = 1.f; int o = -1;
        if (n < 640) o = n;
        else if (n < 672) { const int w = n - 640; o = 640 + (w >> 1) + 16 * (w & 1); }
        else if (n < 680) { o = 1696 + (n - 672); sc = 0.044194173824159216f; }
        else if (n < 704) o = -1;
        else if (n < 1024) { o = 672 + (n - 704); sc = LOG2E * 0.125f; }
        else if (n < 1088) o = 992 + (n - 1024);
        else if (n < 1152) o = 1056 + (n - 1088);
        else if (n < 1664) o = 1120 + (n - 1152);
        else if (n < 1728) o = 1632 + (n - 1664);
        else if (n < 2048) { o = 1704 + (n - 1728); sc = LOG2E * 0.125f; }
        else if (n < 2368) o = 2024 + (n - 2048);
        else if (n < 2688) o = 2344 + (n - 2368);
        src = o >= 0 ? W + o : nullptr; } };
struct MapUq { const float* W;
    __device__ __forceinline__ void operator()(int n, const float*& src, int& ld, float& sc) const {
        ld = 576; sc = 0.10206207261596575f * LOG2E;
        if (n >= 576) { src = nullptr; return; }
        const int hh = n / 96, w = n % 96; const int o = hh * 96 + (w < 64 ? w : 64 + ((w - 64) >> 1) + 16 * ((w - 64) & 1)); src = W + o; } };
struct MapUkv { const float* W;
    __device__ __forceinline__ void operator()(int n, const float*& src, int& ld, float& sc) const {
        ld = 768; sc = 1.f; int o; if (n < 384) { o = (n >> 6) * 128 + (n & 63); } else { const int n2 = n - 384; o = (n2 >> 6) * 128 + 64 + (n2 & 63); } src = W + o; } };
struct MapId { const float* W; int ldw;
    __device__ __forceinline__ void operator()(int n, const float*& src, int& ld, float& sc) const { ld = ldw; sc = 1.f; src = W + n; } };
struct MapGu { const float* Wg; const float* Wu;
    __device__ __forceinline__ void operator()(int n, const float*& src, int& ld, float& sc) const {
        ld = DFF; sc = 1.f; const int tile = n >> 8, x = n & 255; src = (x < 128) ? Wg + tile * 128 + x : Wu + tile * 128 + (x - 128); } };

template <class Map>
__device__ __forceinline__ void conv_item(const Map& mp, int K, bf16_t* WT, LAS float* scr, int item, int nblk, const float* gain = nullptr) {
    const int lane = opaque_tid() & 63;
    const int kb = item / nblk, nb = item % nblk, k0 = 64 * kb, n0 = 32 * nb;
    const float* src; int ld; float sc; mp(n0 + (lane & 31), src, ld, sc);
    const float gl = gain ? gain[k0 + lane] : 1.f;
    float v[32];
#pragma unroll
    for (int i = 0; i < 32; ++i) v[i] = 0.f;
    if (src) { const float* sp = src + (size_t)(k0 + (lane >> 5)) * ld;
#pragma unroll
        for (int i = 0; i < 32; ++i) v[i] = sp[(size_t)(2 * i) * ld]; }
#pragma unroll
    for (int i = 0; i < 32; ++i) { const int kk = 2 * i + (lane >> 5); scr[kk * 33 + (lane & 31)] = v[i] * sc * __shfl(gl, kk); }
    asm volatile("s_waitcnt lgkmcnt(0)" ::: "memory");
    const int c = lane & 7;
#pragma unroll
    for (int j = 0; j < 4; ++j) { const int n = (lane >> 3) + 8 * j; const LAS float* s = scr + (8 * c) * 33 + n;
        u32x4 o; o.x = pk_bf16(s[0 * 33], s[1 * 33]); o.y = pk_bf16(s[2 * 33], s[3 * 33]); o.z = pk_bf16(s[4 * 33], s[5 * 33]); o.w = pk_bf16(s[6 * 33], s[7 * 33]);
        *(u32x4*)(WT + (size_t)(n0 + n) * K + k0 + 8 * c) = o; }
    asm volatile("s_waitcnt lgkmcnt(0)" ::: "memory");
}

__device__ __forceinline__ void x_to_h_rows(const float* X, bf16_t* H, float* SSo, int gw, int ngw) {
    const int lane = opaque_tid() & 63;
    for (int m0 = gw; m0 < M; m0 += 4 * ngw) {
        f32x4 v[4][4];
#pragma unroll
        for (int r = 0; r < 4; ++r) { const int m = min(m0 + r * ngw, M - 1);
#pragma unroll
            for (int j = 0; j < 4; ++j) v[r][j] = ((const f32x4*)(X + (size_t)m * D) + lane)[64 * j]; }
        __builtin_amdgcn_sched_barrier(0);
#pragma unroll
        for (int r = 0; r < 4; ++r) { const int m = m0 + r * ngw; if (m < M) {
            u32x2* o8 = (u32x2*)(H + (size_t)m * D) + lane; float sq = 0.f;
#pragma unroll
            for (int j = 0; j < 4; ++j) { u32x2 w; w.x = pk_bf16(v[r][j][0], v[r][j][1]); w.y = pk_bf16(v[r][j][2], v[r][j][3]); o8[64 * j] = w;
                sq += (bf_lo(w.x) * bf_lo(w.x) + bf_hi(w.x) * bf_hi(w.x)) + (bf_lo(w.y) * bf_lo(w.y) + bf_hi(w.y) * bf_hi(w.y)); }
            sq = wave_sum(sq);
            if (lane < 16) SSo[(size_t)m * 16 + lane] = (lane == 0) ? sq : 0.f; } }
    }
}
__device__ __forceinline__ void final_norm_rows(const bf16_t* H, const float* gain, float* Out, int gw, int ngw) {
    const int lane = opaque_tid() & 63;
    f32x4 g[4];
#pragma unroll
    for (int j = 0; j < 4; ++j) g[j] = *(const f32x4*)(gain + 256 * j + 4 * lane);
    for (int m0 = gw; m0 < M; m0 += 4 * ngw) {
        u32x2 hw[4][4];
#pragma unroll
        for (int r = 0; r < 4; ++r) { const int m = min(m0 + r * ngw, M - 1);
#pragma unroll
            for (int j = 0; j < 4; ++j) hw[r][j] = ((const u32x2*)(H + (size_t)m * D) + lane)[64 * j]; }
        __builtin_amdgcn_sched_barrier(0);
#pragma unroll
        for (int r = 0; r < 4; ++r) { const int m = m0 + r * ngw; if (m < M) {
            f32x4 v[4]; float sq = 0.f;
#pragma unroll
            for (int j = 0; j < 4; ++j) { const u32x2 w = hw[r][j]; v[j] = (f32x4){bf_lo(w.x), bf_hi(w.x), bf_lo(w.y), bf_hi(w.y)}; sq += (v[j][0] * v[j][0] + v[j][1] * v[j][1]) + (v[j][2] * v[j][2] + v[j][3] * v[j][3]); }
            const float rr = rsqrtf(wave_sum(sq) * (1.f / D) + EPS);
            f32x4* orow = (f32x4*)(Out + (size_t)m * D) + lane;
#pragma unroll
            for (int j = 0; j < 4; ++j) orow[64 * j] = v[j] * rr * g[j]; } }
    }
}
__device__ __forceinline__ void cvt_p_rows(const float* Pin, bf16_t* PB, int gbase, int nthreads) {
    const int gtid = gbase + opaque_tid();
    const size_t n8 = (size_t)M * PLE / 8;
    for (size_t i0 = gtid; i0 < n8; i0 += (size_t)4 * nthreads) {
        f32x4 a[4], b[4];
#pragma unroll
        for (int r = 0; r < 4; ++r) { const size_t i = (i0 + (size_t)r * nthreads < n8) ? i0 + (size_t)r * nthreads : i0; a[r] = *(const f32x4*)(Pin + i * 8); b[r] = *(const f32x4*)(Pin + i * 8 + 4); }
        __builtin_amdgcn_sched_barrier(0);
#pragma unroll
        for (int r = 0; r < 4; ++r) { const size_t i = i0 + (size_t)r * nthreads; if (i < n8) {
            u32x4 w; w.x = pk_bf16(a[r][0], a[r][1]); w.y = pk_bf16(a[r][2], a[r][3]); w.z = pk_bf16(b[r][0], b[r][1]); w.w = pk_bf16(b[r][2], b[r][3]); *(u32x4*)(PB + i * 8) = w; } }
    }
}
constexpr int MLA_KS = 208, MLA_VS = 144, MLA_KB = 64 * MLA_KS, MLA_VB = 64 * MLA_VS;
#define MLA_BAR() asm volatile("s_waitcnt lgkmcnt(0)\n\ts_barrier" ::: "memory")
#define MLA_KREADS_R(a, b) _Pragma("unroll") for (int ks = (a); ks < (b); ++ks) { kfr[ks][0] = *(LAS const bf16x8*)(kl + ks * 32); kfr[ks][1] = *(LAS const bf16x8*)(kl + 32 * MLA_KS + ks * 32); }
#define MLA_VREADS_R(a, b) _Pragma("unroll") for (int kk = (a); kk < (b); ++kk) { vt[kk][0] = ldtr(vl + (16 * kk) * MLA_VS); vt[kk][1] = ldtr(vl + (16 * kk + 8) * MLA_VS); vt[kk][2] = ldtr(vl + (16 * kk) * MLA_VS + 64); vt[kk][3] = ldtr(vl + (16 * kk + 8) * MLA_VS + 64); }
#define MLA_PV() do { _Pragma("unroll") for (int kk = 0; kk < 4; ++kk) { o0 = mfma32(cat8(vt[kk][0], vt[kk][1]), pb[kk], o0); o1 = mfma32(cat8(vt[kk][2], vt[kk][3]), pb[kk], o1); } } while (0)
__device__ __forceinline__ void mla_qk(LAS const unsigned char* kl, const bf16x8 (&qf)[6], const f32x16& negm, f32x16& s0, f32x16& s1) {
    bf16x8 kfr[6][2];
    MLA_KREADS_R(0, 6);
    __builtin_amdgcn_sched_barrier(0);
    s0 = mfma32(kfr[0][0], qf[0], negm); s1 = mfma32(kfr[0][1], qf[0], negm);
#pragma unroll
    for (int ks = 1; ks < 6; ++ks) { s0 = mfma32(kfr[ks][0], qf[ks], s0); s1 = mfma32(kfr[ks][1], qf[ks], s1); }
}
__device__ __forceinline__ void mla_pv(LAS const unsigned char* vl, const bf16x8 (&pb)[4], f32x16& o0, f32x16& o1) {
    s16x4 vt[4][4];
    MLA_VREADS_R(0, 4);
    __builtin_amdgcn_sched_barrier(0);
    MLA_PV();
}
__device__ __forceinline__ void mla_mfull(LAS const unsigned char* kl, LAS const unsigned char* vl, const bf16x8 (&qf)[6], const f32x16& negm, f32x16& s0, f32x16& s1, const bf16x8 (&pb)[4], f32x16& o0, f32x16& o1) {
    bf16x8 kfr[6][2]; s16x4 vt[4][4];
    MLA_KREADS_R(0, 4); MLA_VREADS_R(0, 1);
    __builtin_amdgcn_sched_barrier(0);
    __builtin_amdgcn_s_setprio(1);
    s0 = mfma32(kfr[0][0], qf[0], negm); s1 = mfma32(kfr[0][1], qf[0], negm); s0 = mfma32(kfr[1][0], qf[1], s0); s1 = mfma32(kfr[1][1], qf[1], s1);
    __builtin_amdgcn_sched_barrier(0);
    MLA_KREADS_R(4, 6);
    __builtin_amdgcn_sched_barrier(0);
    s0 = mfma32(kfr[2][0], qf[2], s0); s1 = mfma32(kfr[2][1], qf[2], s1); s0 = mfma32(kfr[3][0], qf[3], s0); s1 = mfma32(kfr[3][1], qf[3], s1);
    __builtin_amdgcn_sched_barrier(0);
    MLA_VREADS_R(1, 4);
    __builtin_amdgcn_sched_barrier(0);
    s0 = mfma32(kfr[4][0], qf[4], s0); s1 = mfma32(kfr[4][1], qf[4], s1); s0 = mfma32(kfr[5][0], qf[5], s0); s1 = mfma32(kfr[5][1], qf[5], s1);
    __builtin_amdgcn_sched_barrier(0);
    MLA_PV();
    __builtin_amdgcn_s_setprio(0);
}
__device__ __forceinline__ void mla_vseg(f32x16& s0, f32x16& s1, f32x16& o0, f32x16& o1, f32x16& negm, bf16x8 (&pb)[4], float& mref, float& lsum, int j, int ntw, int tq, int hi) {
    if (j >= ntw - 1) {
#pragma unroll
        for (int r = 0; r < 16; ++r) { const int key = j * 64 + crow(r, hi); if (key > tq) s0[r] = -1e30f; if (key + 32 > tq) s1[r] = -1e30f; }
    }
    float mx = fmaxf(s0[0], s1[0]);
#pragma unroll
    for (int r = 1; r < 16; ++r) mx = fmaxf(fmaxf(mx, s0[r]), s1[r]);
    { const auto rr = __builtin_amdgcn_permlane32_swap(__float_as_uint(mx), __float_as_uint(mx), false, false); mx = fmaxf(__uint_as_float(rr[0]), __uint_as_float(rr[1])); }
    if (j == 0 || __any(mx > 8.f)) {
        const float dl = (j == 0) ? mx : fmaxf(mx, 0.f), alpha = __builtin_amdgcn_exp2f(-dl);
        mref += dl; lsum *= alpha; const float nm = -mref;
#pragma unroll
        for (int r = 0; r < 16; ++r) { float a = s0[r], c = s1[r], e = o0[r], f = o1[r], g = negm[r];
            asm volatile("v_sub_f32 %0, %0, %5\n\tv_sub_f32 %1, %1, %5\n\tv_mul_f32 %2, %2, %6\n\tv_mul_f32 %3, %3, %6\n\tv_mov_b32 %4, %7" : "+v"(a), "+v"(c), "+v"(e), "+v"(f), "+v"(g) : "v"(dl), "v"(alpha), "v"(nm));
            s0[r] = a; s1[r] = c; o0[r] = e; o1[r] = f; negm[r] = g; }
    }
    float psA = 0.f, psB = 0.f;
#pragma unroll
    for (int r = 0; r < 16; ++r) { float a = __builtin_amdgcn_exp2f(s0[r]), c = __builtin_amdgcn_exp2f(s1[r]); asm volatile("" : "+v"(a), "+v"(c)); s0[r] = a; s1[r] = c;
        psA += a; psB += c; asm volatile("" : "+v"(psA), "+v"(psB)); }
    lsum += psA + psB;
    pb[0] = pack8(s0[0], s0[1], s0[2], s0[3], s0[4], s0[5], s0[6], s0[7]); pb[1] = pack8(s0[8], s0[9], s0[10], s0[11], s0[12], s0[13], s0[14], s0[15]);
    pb[2] = pack8(s1[0], s1[1], s1[2], s1[3], s1[4], s1[5], s1[6], s1[7]); pb[3] = pack8(s1[8], s1[9], s1[10], s1[11], s1[12], s1[13], s1[14], s1[15]);
}
__device__ __forceinline__ void mla_unit(LAS unsigned char* L, const bf16_t* QM, const bf16_t* KV, const bf16_t* KR, bf16_t* MIX, int b, int h, int qt) {
    const int tid = opaque_tid(), lane = tid & 63, wid = __builtin_amdgcn_readfirstlane(tid >> 6), r32 = lane & 31, hi = lane >> 5, grp = wid >> 2;
    const size_t rowbase = (size_t)b * SEQ; const int q0 = qt * 256, qw = q0 + wid * 32, tq = qw + r32;
    bf16x8 qf[6];
    { const bf16_t* qp = QM + (rowbase + tq) * QM_LD + h * 96 + hi * 8;
#pragma unroll
      for (int ks = 0; ks < 6; ++ks) qf[ks] = *(const bf16x8*)(qp + 16 * ks); }
    const int NT = (q0 + 256) / 64, ntw = (qw >> 6) + 1;
    const int krow = tid >> 3, kch = tid & 7, rrow = tid >> 2, rch = tid & 3;
    const unsigned char* bK = (const unsigned char*)(KV + rowbase * KV_LD + h * 64);
    const unsigned char* bR = (const unsigned char*)(KR + rowbase * 32);
    const unsigned oK = (unsigned)(krow * KV_LD + kch * 8) * 2u, oR = (unsigned)((rrow & 63) * 32 + rch * 8) * 2u;
    const int lK = krow * MLA_KS + kch * 16, lR = (rrow & 63) * MLA_KS + 128 + rch * 16, lV = 2 * MLA_KB + krow * MLA_VS + kch * 16;
    u32x4 sk, sv, sr;
#define MLA_LOADK(t) do { const size_t go_ = (size_t)(t) * 64; sk = *(const u32x4*)(bK + go_ * (KV_LD * 2) + oK); if (tid < 256) sr = *(const u32x4*)(bR + go_ * 64 + oR); } while (0)
#define MLA_LOADV(t) do { sv = *(const u32x4*)(bK + (size_t)(t) * 64 * (KV_LD * 2) + 768 + oK); } while (0)
#define MLA_WRITEK(t) do { const int ko_ = ((t) & 1) * MLA_KB; *(LAS u32x4*)(L + ko_ + lK) = sk; if (tid < 256) *(LAS u32x4*)(L + ko_ + lR) = sr; } while (0)
#define MLA_WRITEV(t) do { *(LAS u32x4*)(L + ((t) & 1) * MLA_VB + lV) = sv; } while (0)
    sr = (u32x4){0, 0, 0, 0};
    MLA_LOADK(0); MLA_WRITEK(0);
    MLA_BAR();
    f32x16 o0 = {}, o1 = {}, negm = {}, s0 = {}, s1 = {}; float mref = 0.f, lsum = 0.f;
    bf16x8 pb[4] = {};
    const int i16 = lane & 15, g4 = lane >> 4;
    LAS const unsigned char* klb = L + r32 * MLA_KS + hi * 16;
    LAS const unsigned char* vlb = L + 2 * MLA_KB + (4 * hi + (i16 >> 2)) * MLA_VS + (16 * (g4 & 1) + 4 * (i16 & 3)) * 2;
    if (grp != 0) __builtin_amdgcn_s_setprio(1);
    if (grp == 0) {
        MLA_LOADK(1); MLA_LOADV(0);
        mla_qk(klb, qf, negm, s0, s1);
        MLA_BAR();
        for (int j = 0; j < NT - 1; ++j) {
            mla_vseg(s0, s1, o0, o1, negm, pb, mref, lsum, j, ntw, tq, hi);
            MLA_WRITEK(j + 1); MLA_WRITEV(j);
            MLA_BAR();
            MLA_LOADK(min(j + 2, NT - 1)); MLA_LOADV(j + 1);
            mla_mfull(klb + ((j + 1) & 1) * MLA_KB, vlb + (j & 1) * MLA_VB, qf, negm, s0, s1, pb, o0, o1);
            MLA_BAR();
        }
        mla_vseg(s0, s1, o0, o1, negm, pb, mref, lsum, NT - 1, ntw, tq, hi);
        MLA_WRITEV(NT - 1);
        MLA_BAR();
        mla_pv(vlb + ((NT - 1) & 1) * MLA_VB, pb, o0, o1);
        MLA_BAR();
        MLA_BAR();
    } else {
        MLA_LOADK(1); MLA_LOADV(0);
        MLA_BAR();
        mla_qk(klb, qf, negm, s0, s1);
        MLA_WRITEK(1); MLA_WRITEV(0);
        MLA_BAR();
        for (int j = 0; j < NT - 1; ++j) {
            MLA_LOADK(min(j + 2, NT - 1)); MLA_LOADV(j + 1);
            mla_vseg(s0, s1, o0, o1, negm, pb, mref, lsum, j, ntw, tq, hi);
            MLA_BAR();
            mla_mfull(klb + ((j + 1) & 1) * MLA_KB, vlb + (j & 1) * MLA_VB, qf, negm, s0, s1, pb, o0, o1);
            MLA_WRITEK(j + 2); MLA_WRITEV(j + 1);
            MLA_BAR();
        }
        mla_vseg(s0, s1, o0, o1, negm, pb, mref, lsum, NT - 1, ntw, tq, hi);
        MLA_BAR();
        mla_pv(vlb + ((NT - 1) & 1) * MLA_VB, pb, o0, o1);
        MLA_BAR();
    }
    __builtin_amdgcn_s_setprio(0);
    lsum += __shfl_xor(lsum, 32);
    const float inv = 1.f / lsum;
    const int tid2 = opaque_tid();
    bf16_t* orow = MIX + (rowbase + q0 + (tid2 >> 6) * 32 + (tid2 & 31)) * D + h * 64 + 4 * ((tid2 >> 5) & 1);
#pragma unroll
    for (int g = 0; g < 4; ++g) {
        u32x2 w0, w1; w0.x = pk_bf16(o0[4 * g] * inv, o0[4 * g + 1] * inv); w0.y = pk_bf16(o0[4 * g + 2] * inv, o0[4 * g + 3] * inv);
        w1.x = pk_bf16(o1[4 * g] * inv, o1[4 * g + 1] * inv); w1.y = pk_bf16(o1[4 * g + 2] * inv, o1[4 * g + 3] * inv);
        *(u32x2*)(orow + 8 * g) = w0; *(u32x2*)(orow + 32 + 8 * g) = w1;
    }
}

constexpr int SB_VS = 144;
__device__ __forceinline__ void sb_unit(LAS unsigned char* L, const bf16_t* P, bf16_t* MIX, int b, int qt, int h) {
    const int tid = opaque_tid(), lane = tid & 63, wid = __builtin_amdgcn_readfirstlane(tid >> 6), r32 = lane & 31, hi = lane >> 5;
    const size_t rowbase = (size_t)b * SEQ; const int qw = qt * 256 + wid * 32, tq = qw + r32;
    LAS unsigned char* vl = L + wid * (32 * SB_VS);
    bf16x8 qf[4];
    { const bf16_t* qp = P + (rowbase + tq) * NP + C_SQ + h * 64 + hi * 8;
#pragma unroll
      for (int ks = 0; ks < 4; ++ks) qf[ks] = *(const bf16x8*)(qp + 16 * ks); }
    f32x16 o0 = {}, o1 = {}; float R = 0.f;
    const int i16 = lane & 15, g4 = lane >> 4;
    const int vtr_off = (4 * hi + (i16 >> 2)) * SB_VS + (16 * (g4 & 1) + 4 * (i16 & 3)) * 2;
    for (int kb = qw >> 5; kb >= 0; --kb) {
        const int k0 = kb * 32;
        const bf16_t* kp = P + (rowbase + k0 + r32) * NP + C_SK + h * 64 + hi * 8;
        bf16x8 kf[4];
#pragma unroll
        for (int ks = 0; ks < 4; ++ks) kf[ks] = *(const bf16x8*)(kp + 16 * ks);
        { u32x4 vst[4];
#pragma unroll
          for (int i = 0; i < 4; ++i) vst[i] = *(const u32x4*)(P + (rowbase + k0 + 8 * i + (lane >> 3)) * NP + C_SV + h * 64 + (lane & 7) * 8);
          __builtin_amdgcn_sched_barrier(0);
#pragma unroll
          for (int i = 0; i < 4; ++i) *(LAS u32x4*)(vl + (8 * i + (lane >> 3)) * SB_VS + (lane & 7) * 16) = vst[i]; }
        f32x16 z = {};
#pragma unroll
        for (int ks = 0; ks < 4; ++ks) z = mfma32(kf[ks], qf[ks], z);
        float lb[16], l1[16];
        const bool diag = (k0 == qw);
#pragma unroll
        for (int r = 0; r < 16; ++r) { const float zz = z[r]; const float e = __builtin_amdgcn_exp2f(-fabsf(zz)); const float Lg = __builtin_amdgcn_logf(1.f + e);
            lb[r] = fminf(zz, 0.f) - Lg; l1[r] = lb[r] - zz;
            if (diag && crow(r, hi) >= r32) { lb[r] = -1e30f; l1[r] = 0.f; } }
        float G[4], PG[4], T[4];
#pragma unroll
        for (int g = 0; g < 4; ++g) { G[g] = (l1[4 * g] + l1[4 * g + 1]) + (l1[4 * g + 2] + l1[4 * g + 3]); PG[g] = __shfl_xor(G[g], 32); T[g] = G[g] + PG[g]; }
        float tail[4]; tail[3] = 0.f; tail[2] = T[3]; tail[1] = T[3] + T[2]; tail[0] = tail[1] + T[1];
        float w[16];
#pragma unroll
        for (int g = 0; g < 4; ++g) { float s = R + tail[g] + (hi == 0 ? PG[g] : 0.f);
            w[4 * g + 3] = __builtin_amdgcn_exp2f(lb[4 * g + 3] + s); s += l1[4 * g + 3];
            w[4 * g + 2] = __builtin_amdgcn_exp2f(lb[4 * g + 2] + s); s += l1[4 * g + 2];
            w[4 * g + 1] = __builtin_amdgcn_exp2f(lb[4 * g + 1] + s); s += l1[4 * g + 1];
            w[4 * g + 0] = __builtin_amdgcn_exp2f(lb[4 * g + 0] + s); }
        R += tail[0] + T[0];
        const bf16x8 pb0 = pack8(w[0], w[1], w[2], w[3], w[4], w[5], w[6], w[7]), pb1 = pack8(w[8], w[9], w[10], w[11], w[12], w[13], w[14], w[15]);
        asm volatile("s_waitcnt lgkmcnt(0)" ::: "memory");
        LAS const unsigned char* vp = vl + vtr_off;
        { const bf16x8 va = cat8(ldtr(vp), ldtr(vp + 8 * SB_VS)), vb = cat8(ldtr(vp + 64), ldtr(vp + 8 * SB_VS + 64)); o0 = mfma32(va, pb0, o0); o1 = mfma32(vb, pb0, o1); }
        { const bf16x8 va = cat8(ldtr(vp + 16 * SB_VS), ldtr(vp + 24 * SB_VS)), vb = cat8(ldtr(vp + 16 * SB_VS + 64), ldtr(vp + 24 * SB_VS + 64)); o0 = mfma32(va, pb1, o0); o1 = mfma32(vb, pb1, o1); }
        asm volatile("s_waitcnt lgkmcnt(0)" ::: "memory");
        if (__all(R < -160.f)) break;
    }
    bf16_t* orow = MIX + (rowbase + tq) * D + 704 + h * 64 + 4 * hi;
#pragma unroll
    for (int g = 0; g < 4; ++g) {
        u32x2 w0, w1; w0.x = pk_bf16(o0[4 * g], o0[4 * g + 1]); w0.y = pk_bf16(o0[4 * g + 2], o0[4 * g + 3]);
        w1.x = pk_bf16(o1[4 * g], o1[4 * g + 1]); w1.y = pk_bf16(o1[4 * g + 2], o1[4 * g + 3]);
        *(u32x2*)(orow + 8 * g) = w0; *(u32x2*)(orow + 32 + 8 * g) = w1;
    }
}

constexpr int DSA_CAP = 256;
constexpr int DSL_CAP = 512, DSL_KS = 100;
struct DsaPrm { LAS int* b0; LAS int* b1; LAS int* krem; LAS int* cin; LAS unsigned* nsel; LAS unsigned* ncand; LAS float* sc0; LAS float* off0; LAS float* sc1; LAS float* off1; LAS int* part; LAS int* flag; };
__device__ __forceinline__ DsaPrm dsa_prm(LAS unsigned char* L) {
    DsaPrm p; LAS int* w = (LAS int*)(L + L_PRM);
    p.b0 = w; p.b1 = w + 32; p.krem = w + 64; p.cin = w + 96; p.nsel = (LAS unsigned*)(w + 128); p.ncand = (LAS unsigned*)(w + 160);
    p.sc0 = (LAS float*)(w + 192); p.off0 = (LAS float*)(w + 224); p.sc1 = (LAS float*)(w + 256); p.off1 = (LAS float*)(w + 288); p.part = w + 320; p.flag = w + 832; return p;
}
struct DsaLane { float sc0, off0, sc1, off1; int b0, b1; };
template <int MODE, bool DIAG>
__device__ __forceinline__ void dsa_classify(LAS unsigned char* L, const float (&x)[16], const DsaLane& dl, int kb, int tq, int qloc, int wid, int lane) {
    const int g4 = lane >> 4;
    int key0 = kb + 4 * g4;
    if (DIAG) asm volatile("" : "+v"(key0));
    LAS unsigned* hist = (LAS unsigned*)(L + L_H) + qloc * 1024;
    if (MODE == 3) {
        const float b0f = (dl.b0 == 0) ? -3.0e38f : (float)dl.b0;
        unsigned mge = 0u;
#pragma unroll
        for (int i = 0; i < 16; ++i) {
            const bool valid = !DIAG || (key0 + 16 * (i >> 2) + (i & 3) <= tq);
            unsigned gb = (valid && __builtin_fmaf(x[i], dl.sc0, dl.off0) >= b0f) ? 1u : 0u; asm volatile("" : "+v"(gb));
            mge |= gb << i;
        }
        if (mge) {
            LAS float* xs = (LAS float*)(L + L_H + 98304 + wid * 4096);
#pragma unroll
            for (int i = 0; i < 16; ++i) xs[i * 64 + lane] = x[i];
            const DsaPrm pr = dsa_prm(L);
            LAS float* ls = (LAS float*)(L + L_H) + qloc * DSL_CAP; LAS unsigned short* lk = (LAS unsigned short*)(L + L_H + 65536) + qloc * DSL_CAP;
#pragma unroll 1
            while (mge) { const int i = __builtin_ctz(mge); mge &= mge - 1u;
                const float xv = xs[i * 64 + lane];
                const unsigned slot = __hip_atomic_fetch_add(pr.ncand + qloc, 1u, __ATOMIC_RELAXED, __HIP_MEMORY_SCOPE_WORKGROUP);
                if (slot < (unsigned)DSL_CAP) { ls[slot] = xv; lk[slot] = (unsigned short)(kb + 16 * (i >> 2) + 4 * g4 + (i & 3)); } }
        }
    } else if (MODE != 2) {
#pragma unroll
        for (int i = 0; i < 16; ++i) {
            const float xv = x[i];
            const bool valid = !DIAG || (key0 + 16 * (i >> 2) + (i & 3) <= tq);
            int bin = (int)__builtin_fmaf(xv, dl.sc0, dl.off0); bin = min(max(bin, 0), 1023);
            if (MODE == 0) { if (valid) __hip_atomic_fetch_add(hist + bin, 1u, __ATOMIC_RELAXED, __HIP_MEMORY_SCOPE_WORKGROUP); }
            else { int c1 = (int)__builtin_fmaf(xv, dl.sc1, dl.off1); c1 = min(max(c1, 0), 1023);
                if (valid && bin == dl.b0) __hip_atomic_fetch_add(hist + c1, 1u, __ATOMIC_RELAXED, __HIP_MEMORY_SCOPE_WORKGROUP); }
        }
    } else {
        const float b0f = (dl.b0 == 0) ? -3.0e38f : (float)dl.b0;
        unsigned mge = 0u;
#pragma unroll
        for (int i = 0; i < 16; ++i) {
            const bool valid = !DIAG || (key0 + 16 * (i >> 2) + (i & 3) <= tq);
            unsigned gb = (valid && __builtin_fmaf(x[i], dl.sc0, dl.off0) >= b0f) ? 1u : 0u; asm volatile("" : "+v"(gb));
            mge |= gb << i;
        }
        if (mge) {
            LAS float* xs = (LAS float*)(L + L_H + 65536 + wid * 4096);
#pragma unroll
            for (int i = 0; i < 16; ++i) xs[i * 64 + lane] = x[i];
            const DsaPrm pr = dsa_prm(L);
            LAS float* cand_s = (LAS float*)(L + L_H) + qloc * DSA_CAP; LAS unsigned* cand_k = (LAS unsigned*)(L + L_H + 32768) + qloc * DSA_CAP;
            unsigned w0 = 0u, w1 = 0u;
#pragma unroll 1
            while (mge) { const int i = __builtin_ctz(mge); mge &= mge - 1u;
                const float xv = xs[i * 64 + lane];
                int bin = (int)__builtin_fmaf(xv, dl.sc0, dl.off0); bin = min(max(bin, 0), 1023);
                int c1 = (int)__builtin_fmaf(xv, dl.sc1, dl.off1); c1 = min(max(c1, 0), 1023);
                const int koff = 16 * (i >> 2) + 4 * g4 + (i & 3);
                if (bin > dl.b0 || (bin == dl.b0 && c1 > dl.b1)) { if (koff < 32) w0 |= 1u << koff; else w1 |= 1u << (koff - 32); }
                else if (bin == dl.b0 && c1 == dl.b1) { const unsigned cb = __hip_atomic_fetch_add(pr.ncand + qloc, 1u, __ATOMIC_RELAXED, __HIP_MEMORY_SCOPE_WORKGROUP);
                    if (cb < (unsigned)DSA_CAP) { cand_s[cb] = xv; cand_k[cb] = (unsigned)(kb + koff); } }
            }
            LAS unsigned* bm = (LAS unsigned*)(L + L_H + 98304) + qloc * 256 + (kb >> 5);
            if (w0) __hip_atomic_fetch_or(bm, w0, __ATOMIC_RELAXED, __HIP_MEMORY_SCOPE_WORKGROUP);
            if (w1) __hip_atomic_fetch_or(bm + 1, w1, __ATOMIC_RELAXED, __HIP_MEMORY_SCOPE_WORKGROUP);
        }
    }
}
#define DSA_MM(dst, st) do { constexpr int h0_ = ((st) & 1) ? 4 : 0, nh_ = ((st) & 1) ? 5 : 4; \
        _Pragma("unroll") for (int h_ = 0; h_ < nh_; ++h_) dst[h_] = mfma16(kf[(st) >> 1][0], qf[h0_ + h_][0], (f32x4){0.f, 0.f, 0.f, 0.f}); \
        _Pragma("unroll") for (int h_ = 0; h_ < nh_; ++h_) dst[h_] = mfma16(kf[(st) >> 1][1], qf[h0_ + h_][1], dst[h_]); } while (0)
__device__ __forceinline__ float add_asm(float y, float t) { asm volatile("v_add_f32 %0, %1, %0" : "+v"(t) : "v"(y)); return t; }
__device__ __forceinline__ float fma_abs(float y, float sgn, float t) { asm volatile("v_fma_f32 %0, |%1|, %2, %0" : "+v"(t) : "v"(y), "v"(sgn)); return t; }
#define DSA_VA(src, st) do { constexpr int h0_ = ((st) & 1) ? 4 : 0; f32x4 t_ = xa[(st) >> 1]; \
        _Pragma("unroll") for (int h_ = 0; h_ < 4; ++h_) { const float s_ = sg[h0_ + h_]; \
            _Pragma("unroll") for (int r_ = 0; r_ < 4; ++r_) t_[r_] = fma_abs(src[h_][r_], s_, t_[r_]); } \
        if ((st) & 1) { _Pragma("unroll") for (int r_ = 0; r_ < 4; ++r_) t_[r_] = add_asm(src[4][r_], t_[r_]); } \
        xa[(st) >> 1] = t_; } while (0)
#define DSA_SGB(n) do { _Pragma("unroll") for (int i_ = 0; i_ < (n); ++i_) { __builtin_amdgcn_sched_group_barrier(0x008, 1, 0); __builtin_amdgcn_sched_group_barrier(0x002, 2, 0); } } while (0)
template <int MODE>
__device__ __forceinline__ void dsa_group(LAS unsigned char* L, const bf16x8 (&kf)[4][2], const bf16x8 (&qf)[9][2], const float (&sg)[8], const DsaLane& dl, int kb, int t0, int tq, int qloc, int wid, int lane) {
    f32x4 xa[4];
#pragma unroll
    for (int b_ = 0; b_ < 4; ++b_) xa[b_] = (f32x4){0.f, 0.f, 0.f, 0.f};
    f32x4 aA[5], aB[5];
#define DSA_SB() __builtin_amdgcn_sched_barrier(0)
    DSA_MM(aA, 0); DSA_SB();
    DSA_MM(aB, 1); DSA_SB(); DSA_VA(aA, 0); DSA_SB();
    DSA_MM(aA, 2); DSA_SB(); DSA_VA(aB, 1); DSA_SB();
    DSA_MM(aB, 3); DSA_SB(); DSA_VA(aA, 2); DSA_SB();
    DSA_MM(aA, 4); DSA_SB(); DSA_VA(aB, 3); DSA_SB();
    DSA_MM(aB, 5); DSA_SB(); DSA_VA(aA, 4); DSA_SB();
    DSA_MM(aA, 6); DSA_SB(); DSA_VA(aB, 5); DSA_SB();
    DSA_MM(aB, 7); DSA_SB(); DSA_VA(aA, 6); DSA_SB();
    asm volatile("s_nop 7\n\ts_nop 7" ::: "memory");
    DSA_VA(aB, 7); DSA_SB();
#undef DSA_SB
    float x[16];
#pragma unroll
    for (int b_ = 0; b_ < 4; ++b_) { x[4 * b_] = xa[b_][0]; x[4 * b_ + 1] = xa[b_][1]; x[4 * b_ + 2] = xa[b_][2]; x[4 * b_ + 3] = xa[b_][3]; }
    __builtin_amdgcn_sched_barrier(0);
    if (kb + 63 > t0) dsa_classify<MODE, true>(L, x, dl, kb, tq, qloc, wid, lane); else dsa_classify<MODE, false>(L, x, dl, kb, tq, qloc, wid, lane);
    __builtin_amdgcn_sched_barrier(0);
}
#define DSA_LOADK(buf, grp) do { const GAS bf16_t* kp_ = Pb + (size_t)(64 * (grp) + i16) * 64 + 8 * g4; \
    _Pragma("unroll") for (int blk_ = 0; blk_ < 4; ++blk_) { buf[blk_][0] = *(const GAS bf16x8*)(kp_ + (size_t)(16 * blk_) * 64); buf[blk_][1] = *(const GAS bf16x8*)(kp_ + (size_t)(16 * blk_) * 64 + 32); } } while (0)
template <int MODE>
__device__ __forceinline__ void dsa_pass(LAS unsigned char* L, const bf16_t* Pb_, const bf16x8 (&qf)[9][2], const float (&wh)[8], int t0_, int wid, int lane_, bool dry = false, int gstep = 4) {
    const GAS bf16_t* Pb = (const GAS bf16_t*)Pb_; int t0 = t0_, lane = lane_;
    asm volatile("" : "+s"(Pb), "+s"(t0), "+v"(lane));
    const int i16 = lane & 15, g4 = lane >> 4, qh = wid >> 2, kslot = wid & 3;
    const int qloc = 16 * qh + i16, tq = t0 + qloc, T = t0 + 32;
    const DsaPrm pr = dsa_prm(L);
    DsaLane dl; dl.sc0 = pr.sc0[qloc]; dl.off0 = pr.off0[qloc]; dl.sc1 = pr.sc1[qloc]; dl.off1 = pr.off1[qloc]; dl.b0 = dry ? -1 : pr.b0[qloc]; dl.b1 = pr.b1[qloc];
    const int ngroups = (T + 63) >> 6, glast = ngroups - 1;
    bf16x8 kf[4][2], kn[4][2];
    int g = kslot;
    DSA_LOADK(kf, min(g, glast));
#pragma unroll 1
    while (g < ngroups) {
        DSA_LOADK(kn, min(g + gstep, glast));
        __builtin_amdgcn_sched_barrier(0);
        dsa_group<MODE>(L, kf, qf, wh, dl, 64 * g, t0, tq, qloc, wid, lane);
        g += gstep;
        if (g >= ngroups) break;
        DSA_LOADK(kf, min(g + gstep, glast));
        __builtin_amdgcn_sched_barrier(0);
        dsa_group<MODE>(L, kn, qf, wh, dl, 64 * g, t0, tq, qloc, wid, lane);
        g += gstep;
    }
}
__device__ __forceinline__ void dsa_binsearch(LAS unsigned char* L, LAS int* bout, int level) {
    const int tid = opaque_tid(), lane = tid & 63, q = tid >> 4, sub = tid & 15;
    const DsaPrm pr = dsa_prm(L);
    LAS const unsigned* hist = (LAS const unsigned*)(L + L_H) + q * 1024;
    int s = 0;
#pragma unroll
    for (int i = 0; i < 16; ++i) { const u32x4 h4 = *(LAS const u32x4*)(hist + 64 * sub + 4 * ((i + lane) & 15)); s += (int)((h4.x + h4.y) + (h4.z + h4.w)); }
    pr.part[q * 16 + sub] = s;
    __syncthreads();
    if (sub == 0) {
        const int k = pr.krem[q]; int acc = 0, c = 0;
        { u32x4 pp[4];
#pragma unroll
          for (int i = 0; i < 4; ++i) pp[i] = *(LAS const u32x4*)(pr.part + q * 16 + 4 * i);
          bool dn = false;
#pragma unroll
          for (int cc = 15; cc >= 1; --cc) { const int p = (int)pp[cc >> 2][cc & 3]; const bool hit = !dn && (acc + p >= k); c = hit ? cc : c; dn = dn || hit; acc += dn ? 0 : p; } }
        int j = 0;
        { u32x4 hb[16];
#pragma unroll
          for (int i = 0; i < 16; ++i) hb[i] = *(LAS const u32x4*)(hist + 64 * c + 4 * i);
          bool dn = false;
#pragma unroll
          for (int jj = 63; jj >= 1; --jj) { const int v = (int)hb[jj >> 2][jj & 3]; const bool hit = !dn && (acc + v >= k); j = hit ? jj : j; dn = dn || hit; acc += dn ? 0 : v; } }
        const int bb = 64 * c + j; const int cin = (int)hist[bb];
        bout[q] = bb; pr.cin[q] = cin; pr.krem[q] = k - acc;
        if (level == 0) {
            const float sc0 = pr.sc0[q], off0 = pr.off0[q];
            const float sc1 = sc0 * 1024.f; pr.sc1[q] = sc1; pr.off1[q] = (off0 - (float)bb) * 1024.f;
            if (cin > DSA_CAP) pr.flag[0] = 1;
        }
    }
    __syncthreads();
}
__device__ __forceinline__ void dsa_zero_hist(LAS unsigned char* L) {
    const int tid = opaque_tid();
    const u32x4 z4 = opaque_splat(0u);
#pragma unroll
    for (int i = 0; i < 16; ++i) *(LAS u32x4*)(L + L_H + (i * 512 + tid) * 16) = z4;
}
constexpr int DSA_VS = 144;
__device__ __forceinline__ void dsa_unit(LAS unsigned char* L, const bf16_t* P, const bf16_t* IKC, const bf16_t* DKV, bf16_t* MIX, const unsigned* kmaxw, int b, int qt) {
    const int tid = opaque_tid(), lane = tid & 63, wid = __builtin_amdgcn_readfirstlane(tid >> 6), r32 = lane & 31, hi = lane >> 5;
    const size_t rowbase = (size_t)b * SEQ; const int t0 = qt * 32;
    const bf16_t* Pb = P + rowbase * NP;
    const bf16_t* IKb = IKC + rowbase * 64; const bf16_t* DKVb = DKV + rowbase * 128;
    const DsaPrm pr = dsa_prm(L);
    LAS unsigned short* selall = (LAS unsigned short*)(L + L_SEL);
    if (qt < 8) {
        for (int i = tid; i < 32 * 256; i += NTHREADS) selall[i] = (unsigned short)(((i & 255) <= t0 + (i >> 8)) ? (i & 255) : 0xFFFF);
        if (tid < 32) pr.nsel[tid] = (unsigned)(t0 + tid + 1);
        __syncthreads();
    } else {
        bf16x8 qf[9][2]; float wh[8];
        const int i16q = lane & 15, g4q = lane >> 4, qh = wid >> 2, qloc = 16 * qh + i16q;
        float Rloc = 0.f;
        float kmx_pre = 0.f;
        { const bf16_t* qp = Pb + (size_t)(t0 + qloc) * NP + C_IQ + 8 * g4q;
          const u32x4 wv = *(const u32x4*)(Pb + (size_t)(t0 + qloc) * NP + C_IW);
          u32x4 qraw[8][2];
#pragma unroll
          for (int h = 0; h < 8; ++h)
#pragma unroll
              for (int ks = 0; ks < 2; ++ks) qraw[h][ks] = *(const u32x4*)(qp + h * 64 + 32 * ks);
          if (tid < 32) kmx_pre = sqrtf(__uint_as_float(kmaxw[64 * b]) + __uint_as_float(kmaxw[64 * b + 1]));
          __builtin_amdgcn_sched_barrier(0);
          if (t0 + 32 >= 2048) {
              dsa_zero_hist(L);
              const u32x4 z4 = opaque_splat(0u); for (int i = tid; i < 16384 / 16; i += NTHREADS) ((LAS u32x4*)(L + L_SEL))[i] = z4; }
          __builtin_amdgcn_sched_barrier(0);
          const float wr[8] = {bf_lo(wv.x), bf_hi(wv.x), bf_lo(wv.y), bf_hi(wv.y), bf_lo(wv.z), bf_hi(wv.z), bf_lo(wv.w), bf_hi(wv.w)};
          float qs[2][8];
#pragma unroll
          for (int ks = 0; ks < 2; ++ks)
#pragma unroll
              for (int j = 0; j < 8; ++j) qs[ks][j] = 0.f;
          float rsum = 0.f;
#pragma unroll
          for (int h = 0; h < 8; ++h) { wh[h] = (wr[h] < 0.f) ? -1.f : 1.f; float ss = 0.f;
#pragma unroll
              for (int ks = 0; ks < 2; ++ks) { const u32x4 u = qraw[h][ks];
                  float v[8] = {bf_lo(u.x), bf_hi(u.x), bf_lo(u.y), bf_hi(u.y), bf_lo(u.z), bf_hi(u.z), bf_lo(u.w), bf_hi(u.w)};
#pragma unroll
                  for (int j = 0; j < 8; ++j) { v[j] *= wr[h]; qs[ks][j] += v[j]; }
                  const bf16x8 pk = pack8(v[0], v[1], v[2], v[3], v[4], v[5], v[6], v[7]); qf[h][ks] = pk;
                  const u32x4 pu = __builtin_bit_cast(u32x4, pk);
                  ss += bf_lo(pu.x) * bf_lo(pu.x) + bf_hi(pu.x) * bf_hi(pu.x) + bf_lo(pu.y) * bf_lo(pu.y) + bf_hi(pu.y) * bf_hi(pu.y) + bf_lo(pu.z) * bf_lo(pu.z) + bf_hi(pu.z) * bf_hi(pu.z) + bf_lo(pu.w) * bf_lo(pu.w) + bf_hi(pu.w) * bf_hi(pu.w); }
              ss += __shfl_xor(ss, 16); ss += __shfl_xor(ss, 32);
              rsum += sqrtf(ss); }
          float ss = 0.f;
#pragma unroll
          for (int ks = 0; ks < 2; ++ks) { const bf16x8 pk = pack8(qs[ks][0], qs[ks][1], qs[ks][2], qs[ks][3], qs[ks][4], qs[ks][5], qs[ks][6], qs[ks][7]); qf[8][ks] = pk;
              const u32x4 pu = __builtin_bit_cast(u32x4, pk);
              ss += bf_lo(pu.x) * bf_lo(pu.x) + bf_hi(pu.x) * bf_hi(pu.x) + bf_lo(pu.y) * bf_lo(pu.y) + bf_hi(pu.y) * bf_hi(pu.y) + bf_lo(pu.z) * bf_lo(pu.z) + bf_hi(pu.z) * bf_hi(pu.z) + bf_lo(pu.w) * bf_lo(pu.w) + bf_hi(pu.w) * bf_hi(pu.w); }
          ss += __shfl_xor(ss, 16); ss += __shfl_xor(ss, 32);
          Rloc = rsum + sqrtf(ss); }
        if ((wid & 3) == 0 && g4q == 0) pr.part[qloc] = __float_as_int(Rloc);
        __syncthreads();
        float Rb = 1.f;
        if (tid < 32) Rb = fmaxf(__int_as_float(pr.part[tid]) * kmx_pre * 1.01f, 1e-30f);
#pragma unroll 1
        for (int rep_sel = 0; rep_sel < REP_DSEL; ++rep_sel) {
        if (rep_sel > 0) __syncthreads();
        if (tid < 32) {
            pr.sc0[tid] = 512.f / Rb; pr.off0[tid] = 512.f; pr.sc1[tid] = 0.f; pr.off1[tid] = 0.f; pr.b0[tid] = 0; pr.b1[tid] = 0; pr.krem[tid] = (t0 + 32 >= 2048) ? DSL_KS : 256; pr.nsel[tid] = 0u; pr.ncand[tid] = 0u;
            if (tid == 0) pr.flag[0] = 0;
        }
        bool done_sel = false;
        if (t0 + 32 >= 2048) {
            if (tid < 32) pr.sc0[tid] = 2048.f / Rb;
            __syncthreads();
            dsa_pass<0>(L, IKb, qf, wh, t0, wid, lane, false, 16);
            __syncthreads();
            dsa_binsearch(L, pr.b0, 2);
            if (tid < 32) { pr.ncand[tid] = 0u; pr.krem[tid] = 256; }
            if (tid == 0) pr.flag[0] = 0;
            __syncthreads();
            dsa_pass<3>(L, IKb, qf, wh, t0, wid, lane);
            __syncthreads();
            {
                const int q = tid >> 4, sub = tid & 15;
                LAS unsigned* wh_ = (LAS unsigned*)(L + L_SEL) + q * 128;
                { const int n = min((int)pr.ncand[q], DSL_CAP), bf = pr.b0[q]; const float sc0 = pr.sc0[q], off0 = pr.off0[q];
                  LAS const float* ls = (LAS const float*)(L + L_H) + q * DSL_CAP;
#pragma unroll 1
                  for (int i = sub; i < n; i += 64) {
                      float xs4[4];
#pragma unroll
                      for (int u = 0; u < 4; ++u) xs4[u] = ls[min(i + 16 * u, DSL_CAP - 1)];
#pragma unroll
                      for (int u = 0; u < 4; ++u) if (i + 16 * u < n) { int bin = (int)__builtin_fmaf(xs4[u], sc0, off0); bin = min(max(bin, 0), 1023); __hip_atomic_fetch_add(wh_ + min(bin - bf, 127), 1u, __ATOMIC_RELAXED, __HIP_MEMORY_SCOPE_WORKGROUP); } } }
                __syncthreads();
                int sacc = 0;
#pragma unroll
                for (int i = 0; i < 8; ++i) sacc += (int)wh_[8 * sub + i];
                pr.part[q * 16 + sub] = sacc;
                __syncthreads();
                if (sub == 0) { int acc = 0, c = 0, j = 0;
                    { u32x4 pp[4];
#pragma unroll
                      for (int i = 0; i < 4; ++i) pp[i] = *(LAS const u32x4*)(pr.part + q * 16 + 4 * i);
                      bool dn = false;
#pragma unroll
                      for (int cc = 15; cc >= 1; --cc) { const int p = (int)pp[cc >> 2][cc & 3]; const bool hit = !dn && (acc + p >= 256); c = hit ? cc : c; dn = dn || hit; acc += dn ? 0 : p; } }
                    { u32x4 hb[2];
#pragma unroll
                      for (int i = 0; i < 2; ++i) hb[i] = *(LAS const u32x4*)(wh_ + 8 * c + 4 * i);
                      bool dn = false;
#pragma unroll
                      for (int jj = 7; jj >= 1; --jj) { const int v = (int)hb[jj >> 2][jj & 3]; const bool hit = !dn && (acc + v >= 256); j = hit ? jj : j; dn = dn || hit; acc += dn ? 0 : v; } }
                    const int b0w = 8 * c + j; const int tot = acc + (int)wh_[b0w];
                    pr.b1[q] = b0w; pr.krem[q] = 256 - acc;
                    if (tot < 256 || b0w >= 127 || pr.ncand[q] > (unsigned)DSL_CAP) pr.flag[0] = 1; }
                __syncthreads();
            }
            if (pr.flag[0] == 0) {
                done_sel = true;
                const int q = tid >> 4, sub = tid & 15;
                const int n = (int)pr.ncand[q], bf = pr.b0[q], b0w = pr.b1[q], k = pr.krem[q];
                const float sc0 = pr.sc0[q], off0 = pr.off0[q];
                const float fs = sc0 * 128.f, fo = (off0 - (float)(bf + b0w)) * 128.f;
                LAS const float* ls = (LAS const float*)(L + L_H) + q * DSL_CAP; LAS const unsigned short* lk = (LAS const unsigned short*)(L + L_H + 65536) + q * DSL_CAP;
                LAS unsigned* sh = (LAS unsigned*)(L + L_SEL) + q * 128;
                LAS unsigned* bmq = (LAS unsigned*)(L + L_H + 98304) + q * 256;
                __syncthreads();
                { const u32x4 z4 = opaque_splat(0u); for (int i = tid; i < 32768 / 16; i += NTHREADS) ((LAS u32x4*)(L + L_H + 98304))[i] = z4;
#pragma unroll
                  for (int i = 0; i < 2; ++i) *(LAS u32x4*)(sh + 8 * sub + 4 * i) = z4; }
                if (sub == 0) pr.cin[q] = 0;
                __syncthreads();
#pragma unroll 1
                for (int i = sub; i < n; i += 64) {
                    float xs4[4]; unsigned ks4[4];
#pragma unroll
                    for (int u = 0; u < 4; ++u) { const int ii = min(i + 16 * u, DSL_CAP - 1); xs4[u] = ls[ii]; ks4[u] = lk[ii]; }
#pragma unroll
                    for (int u = 0; u < 4; ++u) if (i + 16 * u < n) { const float xv = xs4[u]; int bin = (int)__builtin_fmaf(xv, sc0, off0); bin = min(max(bin, 0), 1023); const int w = min(bin - bf, 127);
                        if (w > b0w) { const unsigned ki = ks4[u]; __hip_atomic_fetch_or(bmq + (ki >> 5), 1u << (ki & 31u), __ATOMIC_RELAXED, __HIP_MEMORY_SCOPE_WORKGROUP); }
                        else if (w == b0w) { int c = (int)__builtin_fmaf(xv, fs, fo); c = min(max(c, 0), 127); __hip_atomic_fetch_add(sh + c, 1u, __ATOMIC_RELAXED, __HIP_MEMORY_SCOPE_WORKGROUP); } } }
                __syncthreads();
                { int sacc = 0;
#pragma unroll
                  for (int i = 0; i < 8; ++i) sacc += (int)sh[8 * sub + i];
                  pr.part[q * 16 + sub] = sacc; }
                __syncthreads();
                if (sub == 0) { int acc = 0, c = 0, j = 0;
                    { u32x4 pp[4];
#pragma unroll
                      for (int i = 0; i < 4; ++i) pp[i] = *(LAS const u32x4*)(pr.part + q * 16 + 4 * i);
                      bool dn = false;
#pragma unroll
                      for (int cc = 15; cc >= 1; --cc) { const int p = (int)pp[cc >> 2][cc & 3]; const bool hit = !dn && (acc + p >= k); c = hit ? cc : c; dn = dn || hit; acc += dn ? 0 : p; } }
                    { u32x4 hb[2];
#pragma unroll
                      for (int i = 0; i < 2; ++i) hb[i] = *(LAS const u32x4*)(sh + 8 * c + 4 * i);
                      bool dn = false;
#pragma unroll
                      for (int jj = 7; jj >= 1; --jj) { const int v = (int)hb[jj >> 2][jj & 3]; const bool hit = !dn && (acc + v >= k); j = hit ? jj : j; dn = dn || hit; acc += dn ? 0 : v; } }
                    pr.b1[q] = 8 * c + j; pr.krem[q] = k - acc; }
                __syncthreads();
                const int b2 = pr.b1[q], k2 = pr.krem[q];
                LAS unsigned short* tie = (LAS unsigned short*)sh;
                __syncthreads();
#pragma unroll 1
                for (int i = sub; i < n; i += 64) {
                    float xs4[4]; unsigned ks4[4];
#pragma unroll
                    for (int u = 0; u < 4; ++u) { const int ii = min(i + 16 * u, DSL_CAP - 1); xs4[u] = ls[ii]; ks4[u] = lk[ii]; }
#pragma unroll
                    for (int u = 0; u < 4; ++u) if (i + 16 * u < n) { const float xv = xs4[u]; int bin = (int)__builtin_fmaf(xv, sc0, off0); bin = min(max(bin, 0), 1023);
                        if (min(bin - bf, 127) == b0w) { int c = (int)__builtin_fmaf(xv, fs, fo); c = min(max(c, 0), 127);
                            if (c > b2) { const unsigned ki = ks4[u]; __hip_atomic_fetch_or(bmq + (ki >> 5), 1u << (ki & 31u), __ATOMIC_RELAXED, __HIP_MEMORY_SCOPE_WORKGROUP); }
                            else if (c == b2) { const unsigned pos = __hip_atomic_fetch_add((LAS unsigned*)pr.cin + q, 1u, __ATOMIC_RELAXED, __HIP_MEMORY_SCOPE_WORKGROUP); if (pos < 256u) tie[pos] = (unsigned short)(i + 16 * u); } } } }
                __syncthreads();
                const int nt = min(pr.cin[q], 256);
#pragma unroll 1
                for (int a = sub; a < nt; a += 16) { const int ia = tie[a]; const float si = ls[ia]; const unsigned ki = lk[ia]; int rank = 0;
#pragma unroll 1
                    for (int bb = 0; bb < nt; ++bb) { const int ib = tie[bb]; const float sj = ls[ib]; const unsigned kj = lk[ib]; rank += (sj > si || (sj == si && kj < ki)) ? 1 : 0; }
                    if (rank < k2) __hip_atomic_fetch_or(bmq + (ki >> 5), 1u << (ki & 31u), __ATOMIC_RELAXED, __HIP_MEMORY_SCOPE_WORKGROUP); }
                __syncthreads();
            }
        }
        if (!done_sel) {
        __syncthreads();
        if (tid < 32) { pr.sc0[tid] = 512.f / Rb; pr.sc1[tid] = 0.f; pr.off1[tid] = 0.f; pr.b0[tid] = 0; pr.b1[tid] = 0; pr.krem[tid] = 256; pr.ncand[tid] = 0u; }
        if (tid == 0) pr.flag[0] = 0;
        __syncthreads();
        for (int pr_ = 0; pr_ < PROBE_DRY; ++pr_) { __syncthreads(); dsa_pass<1>(L, IKb, qf, wh, t0, wid, lane, true); __syncthreads(); }
        for (int pr_ = 0; pr_ < PROBE_HIST; ++pr_) { __syncthreads(); dsa_pass<0>(L, IKb, qf, wh, t0, wid, lane); __syncthreads(); }
        for (int pr_ = 0; pr_ < PROBE_ZERO; ++pr_) { dsa_zero_hist(L); __syncthreads(); __syncthreads(); }
        dsa_zero_hist(L);
        __syncthreads();
        dsa_pass<0>(L, IKb, qf, wh, t0, wid, lane);
        __syncthreads();
        dsa_binsearch(L, pr.b0, 0);
        const bool lvl1 = pr.flag[0] != 0;
        if (lvl1) {
            dsa_zero_hist(L);
            __syncthreads();
            dsa_pass<1>(L, IKb, qf, wh, t0, wid, lane);
            __syncthreads();
            dsa_binsearch(L, pr.b1, 1);
        } else { if (tid < 32) { pr.sc1[tid] = 0.f; pr.off1[tid] = 0.f; pr.b1[tid] = 0; } }
        { const u32x4 z4 = opaque_splat(0u); for (int i = tid; i < 32768 / 16; i += NTHREADS) ((LAS u32x4*)(L + L_H + 98304))[i] = z4; }
        __syncthreads();
        dsa_pass<2>(L, IKb, qf, wh, t0, wid, lane);
        __syncthreads();
        {
            const int q = tid >> 4, sub = tid & 15;
            const int n = min((int)pr.ncand[q], DSA_CAP), k = pr.krem[q];
            LAS const float* cs = (LAS const float*)(L + L_H) + q * DSA_CAP; LAS const unsigned* ck = (LAS const unsigned*)(L + L_H + 32768) + q * DSA_CAP;
            LAS unsigned* sh = (LAS unsigned*)(L + L_H + 65536) + q * 256;
            LAS unsigned short* tie = (LAS unsigned short*)(L + L_SEL) + q * 256;
            LAS unsigned* bmq = (LAS unsigned*)(L + L_H + 98304) + q * 256;
            const float fs = (lvl1 ? pr.sc1[q] : pr.sc0[q]) * 256.f, fo = (lvl1 ? (pr.off1[q] - (float)pr.b1[q]) : (pr.off0[q] - (float)pr.b0[q])) * 256.f;
            { const u32x4 z4 = opaque_splat(0u);
#pragma unroll
            for (int i = 0; i < 4; ++i) *(LAS u32x4*)(sh + 16 * sub + 4 * i) = z4; }
            if (sub == 0) pr.cin[q] = 0;
            __syncthreads();
#pragma unroll 1
            for (int i = sub; i < n; i += 16) { int c = (int)__builtin_fmaf(cs[i], fs, fo); c = min(max(c, 0), 255); __hip_atomic_fetch_add(sh + c, 1u, __ATOMIC_RELAXED, __HIP_MEMORY_SCOPE_WORKGROUP); }
            __syncthreads();
            { int sacc = 0;
#pragma unroll
              for (int i = 0; i < 16; ++i) sacc += (int)sh[16 * sub + i];
              pr.part[q * 16 + sub] = sacc; }
            __syncthreads();
            if (sub == 0) { int acc = 0, c = 15;
#pragma unroll 1
                for (; c > 0; --c) { const int p = pr.part[q * 16 + c]; if (acc + p >= k) break; acc += p; }
                int j = 15;
#pragma unroll 1
                for (; j > 0; --j) { const int v = (int)sh[16 * c + j]; if (acc + v >= k) break; acc += v; }
                pr.b1[q] = 16 * c + j; pr.krem[q] = k - acc; }
            __syncthreads();
            const int b2 = pr.b1[q], k2 = pr.krem[q];
#pragma unroll 1
            for (int i = sub; i < n; i += 16) { int c = (int)__builtin_fmaf(cs[i], fs, fo); c = min(max(c, 0), 255);
                if (c > b2) { const unsigned ki = ck[i]; __hip_atomic_fetch_or(bmq + (ki >> 5), 1u << (ki & 31u), __ATOMIC_RELAXED, __HIP_MEMORY_SCOPE_WORKGROUP); }
                else if (c == b2) { const unsigned pos = __hip_atomic_fetch_add((LAS unsigned*)pr.cin + q, 1u, __ATOMIC_RELAXED, __HIP_MEMORY_SCOPE_WORKGROUP); tie[pos] = (unsigned short)i; } }
            __syncthreads();
            const int nt = pr.cin[q];
#pragma unroll 1
            for (int a = sub; a < nt; a += 16) { const int ia = tie[a]; const float si = cs[ia]; const unsigned ki = ck[ia]; int rank = 0;
#pragma unroll 1
                for (int bb = 0; bb < nt; ++bb) { const int ib = tie[bb]; const float sj = cs[ib]; const unsigned kj = ck[ib]; rank += (sj > si || (sj == si && kj < ki)) ? 1 : 0; }
                if (rank < k2) __hip_atomic_fetch_or(bmq + (ki >> 5), 1u << (ki & 31u), __ATOMIC_RELAXED, __HIP_MEMORY_SCOPE_WORKGROUP); }
        }
        }
        __syncthreads();
        { const u32x4 f4 = opaque_splat(0xFFFFFFFFu); for (int i = tid; i < 32 * 256 / 8; i += NTHREADS) ((LAS u32x4*)selall)[i] = f4; }
        __syncthreads();
        for (int rl_ = 0; rl_ < REP_LIST; ++rl_)
        {
            const int q = tid >> 4, sub = tid & 15;
            LAS const unsigned* bm = (LAS const unsigned*)(L + L_H + 98304) + q * 256 + sub * 16;
            int cnt = 0; unsigned bw[16];
            { u32x4 b4[4];
#pragma unroll
              for (int i = 0; i < 4; ++i) b4[i] = *(LAS const u32x4*)(bm + 4 * i);
#pragma unroll
              for (int i = 0; i < 16; ++i) { bw[i] = b4[i >> 2][i & 3]; cnt += __builtin_popcount(bw[i]); } }
            pr.part[q * 16 + sub] = cnt;
            __syncthreads();
            int off = 0;
#pragma unroll
            for (int i4 = 0; i4 < 4; ++i4) { const u32x4 p4 = *(LAS const u32x4*)(pr.part + q * 16 + 4 * i4);
                off += ((4 * i4 + 0 < sub) ? (int)p4.x : 0) + ((4 * i4 + 1 < sub) ? (int)p4.y : 0) + ((4 * i4 + 2 < sub) ? (int)p4.z : 0) + ((4 * i4 + 3 < sub) ? (int)p4.w : 0); }
            if (sub == 15) pr.nsel[q] = (unsigned)min(off + cnt, 256);
#pragma unroll
            for (int i = 0; i < 16; ++i) { unsigned w = bw[i];
#pragma unroll 1
                while (w) { const int bit = __builtin_ctz(w); w &= w - 1u; if (off < 256) selall[q * 256 + off] = (unsigned short)((sub * 16 + i) * 32 + bit); ++off; } }
        }
        __syncthreads();
        }
    }
    LAS const float* biasT = (LAS const float*)(L + L_BIAS);
    LAS unsigned char* vl = L + L_H + wid * (64 * DSA_VS);
    const int i16 = lane & 15, g4 = lane >> 4;
    const GAS bf16_t* Pg = (const GAS bf16_t*)Pb; const GAS bf16_t* Dg = (const GAS bf16_t*)DKVb;
    bf16x8 kalo[8][2];
#define DSA_LOADKA(dst, qq, kb0) do { LAS const unsigned short* sel_ = selall + (qq) * 256; \
        _Pragma("unroll") for (int kb_ = 0; kb_ < 8; ++kb_) { const int key_ = (int)sel_[16 * ((kb0) + kb_) + i16] & (SEQ - 1);     \
            const GAS bf16_t* kp_ = Dg + (size_t)key_ * 128 + 8 * g4; dst[kb_][0] = *(const GAS bf16x8*)kp_; dst[kb_][1] = *(const GAS bf16x8*)(kp_ + 32); } } while (0)
    DSA_LOADKA(kalo, wid * 4, 0);
    LAS unsigned char* qs = L + L_H + 81920 + wid * 2560;
    { u32x4 qv[3];
#pragma unroll
      for (int i = 0; i < 3; ++i) { const int c = min(lane + 64 * i, 159); qv[i] = *(const GAS u32x4*)(Pg + (size_t)(t0 + 4 * wid + c / 40) * NP + C_DQ + (c % 40) * 8); }
#pragma unroll
      for (int i = 0; i < 3; ++i) if (lane + 64 * i < 160) *(LAS u32x4*)(qs + (lane + 64 * i) * 16) = qv[i]; }
#pragma unroll 1
    for (int qi = 0; qi < 4; ++qi) {
        const int q = wid * 4 + qi, t = t0 + q;
        LAS const unsigned short* sel = selall + q * 256;
        bf16x8 qb0 = {}, qb1 = {};
        if (i16 < 5) { LAS const unsigned char* qp = qs + (qi * 40 + i16 * 8 + g4) * 16; qb0 = *(LAS const bf16x8*)qp; qb1 = *(LAS const bf16x8*)(qp + 64); }
        f32x4 sc[16];
        { bf16x8 kahi[8][2];
          DSA_LOADKA(kahi, q, 8);
          __builtin_amdgcn_sched_barrier(0);
#pragma unroll
          for (int kb = 0; kb < 8; ++kb) { f32x4 acc = {0.f, 0.f, 0.f, 0.f}; acc = mfma16(kalo[kb][0], qb0, acc); acc = mfma16(kalo[kb][1], qb1, acc); sc[kb] = acc; }
#pragma unroll
          for (int kb = 0; kb < 8; ++kb) { f32x4 acc = {0.f, 0.f, 0.f, 0.f}; acc = mfma16(kahi[kb][0], qb0, acc); acc = mfma16(kahi[kb][1], qb1, acc); sc[8 + kb] = acc; } }
        __builtin_amdgcn_sched_barrier(0);
        u32x4 vv[8];
#pragma unroll
        for (int i = 0; i < 8; ++i) { const int key = (int)sel[8 * i + (lane >> 3)] & (SEQ - 1); vv[i] = *(const GAS u32x4*)(Dg + (size_t)key * 128 + 64 + (lane & 7) * 8); }
        float mx = -1e30f;
        const float bfar = biasT[128 * 8 + (i16 & 7)];
        int klast[16];
#pragma unroll
        for (int kb = 0; kb < 16; ++kb) klast[kb] = (int)sel[16 * kb + 15];
        __builtin_amdgcn_sched_barrier(0);
#pragma unroll
        for (int kb = 0; kb < 16; ++kb) {
            if (klast[kb] + 128 <= t) {
#pragma unroll
                for (int r = 0; r < 4; ++r) { const float sv = sc[kb][r] + bfar; sc[kb][r] = sv; mx = fmaxf(mx, sv); }
            } else {
                const u32x2 sk = *(LAS const u32x2*)(sel + 16 * kb + 4 * g4);
                const int keys[4] = {(int)(sk.x & 0xffffu), (int)(sk.x >> 16), (int)(sk.y & 0xffffu), (int)(sk.y >> 16)};
                float bv[4];
#pragma unroll
                for (int r = 0; r < 4; ++r) bv[r] = biasT[min(max(t - keys[r], 0), 128) * 8 + (i16 & 7)];
#pragma unroll
                for (int r = 0; r < 4; ++r) { float sv = sc[kb][r] + bv[r];
                    sv = (keys[r] == 0xFFFF) ? -1e30f : sv;
                    sc[kb][r] = sv; mx = fmaxf(mx, sv); }
            } }
        mx = fmaxf(mx, __shfl_xor(mx, 16)); mx = fmaxf(mx, __shfl_xor(mx, 32));
        float sum = 0.f;
#pragma unroll
        for (int kb = 0; kb < 16; ++kb)
#pragma unroll
            for (int r = 0; r < 4; ++r) { const float p = __builtin_amdgcn_exp2f(sc[kb][r] - mx); sc[kb][r] = p; sum += p; }
        sum += __shfl_xor(sum, 16); sum += __shfl_xor(sum, 32);
        const float inv = 1.f / sum;
        bf16x8 pa[8];
#pragma unroll
        for (int j = 0; j < 8; ++j) pa[j] = pack8(sc[2 * j][0] * inv, sc[2 * j][1] * inv, sc[2 * j][2] * inv, sc[2 * j][3] * inv, sc[2 * j + 1][0] * inv, sc[2 * j + 1][1] * inv, sc[2 * j + 1][2] * inv, sc[2 * j + 1][3] * inv);
        __builtin_amdgcn_sched_barrier(0);
        if (qi < 3) DSA_LOADKA(kalo, q + 1, 0);
        __builtin_amdgcn_sched_barrier(0);
        f32x4 o[4] = {{0.f, 0.f, 0.f, 0.f}, {0.f, 0.f, 0.f, 0.f}, {0.f, 0.f, 0.f, 0.f}, {0.f, 0.f, 0.f, 0.f}};
#pragma unroll
        for (int c = 0; c < 4; ++c) {
#pragma unroll
            for (int i = 0; i < 8; ++i) { const int row = 8 * i + (lane >> 3), ch = lane & 7; *(LAS u32x4*)(vl + row * DSA_VS + ch * 16) = vv[i]; }
            if (c + 1 < 4) {
#pragma unroll
                for (int i = 0; i < 8; ++i) { const int key = (int)sel[64 * (c + 1) + 8 * i + (lane >> 3)] & (SEQ - 1); vv[i] = *(const GAS u32x4*)(Dg + (size_t)key * 128 + 64 + (lane & 7) * 8); }
            }
            asm volatile("s_waitcnt lgkmcnt(0)" ::: "memory");
#pragma unroll
            for (int s2 = 0; s2 < 2; ++s2) {
                LAS const unsigned char* vp = vl + (32 * s2 + 4 * g4 + (i16 >> 2)) * DSA_VS + (4 * (i16 & 3)) * 2;
#pragma unroll
                for (int nb = 0; nb < 4; ++nb) { const bf16x8 vb = cat8(ldtr(vp + nb * 32), ldtr(vp + 16 * DSA_VS + nb * 32)); o[nb] = mfma16(pa[2 * c + s2], vb, o[nb]); }
            }
            asm volatile("s_waitcnt lgkmcnt(0)" ::: "memory");
        }
        bf16_t* orow = MIX + (rowbase + t) * D + 384;
#pragma unroll
        for (int nb = 0; nb < 4; ++nb)
#pragma unroll
            for (int r = 0; r < 4; ++r) { const int head = 4 * g4 + r; if (head < 5) { const unsigned pk = pk_bf16(o[nb][r], 0.f); orow[head * 64 + 16 * nb + i16] = (bf16_t)(pk & 0xffffu); } }
    }
#undef DSA_LOADKA
    __syncthreads();
}

struct Args { const float* in[18]; float* out; unsigned char* ws; };
constexpr int N_MLA = NBATCH * 6 * 32, N_DSA = NBATCH * 256, N_SB = NBATCH * 32 * 5, N_ATT = N_MLA + N_DSA + N_SB;

#define CAS __attribute__((address_space(4)))
#define KARGS(k) const CAS Args* k = (const CAS Args*)__builtin_amdgcn_kernarg_segment_ptr(); asm volatile("" : "+s"(k))
constexpr int CI_IN = 16 * 88, CI_UQ = 6 * 24, CI_UKV = 4 * 24, CI_O = 16 * 32, CI_GU = 16 * 176, CI_DN = 44 * 32, CI_PG = 16 * 32, CI_PP = 4 * 32;
constexpr int CONV_ITEMS = CI_IN + CI_UQ + CI_UKV + CI_O + CI_GU + CI_DN + CI_PG + CI_PP;
constexpr int CONV_PER_UNIT = 16, N_CONVU = (CONV_ITEMS + CONV_PER_UNIT - 1) / CONV_PER_UNIT;
__device__ __forceinline__ void conv_layer_item(const CAS Args* ka, int ly, int r, LAS float* scr) {
    unsigned char* wl = ka->ws + WS_W + (size_t)ly * LAYER_W_BYTES;
    if (r < CI_IN) { MapIn mp{ka->in[2] + (size_t)ly * D * DIN}; conv_item(mp, 1024, (bf16_t*)(wl + W_IN), scr, r, 88, ka->in[3] + ly * D); return; } r -= CI_IN;
    if (r < CI_UQ) { MapUq mp{ka->in[5] + (size_t)ly * 384 * 576}; conv_item(mp, 384, (bf16_t*)(wl + W_UQ), scr, r, 24, ka->in[4] + ly * 384); return; } r -= CI_UQ;
    if (r < CI_UKV) { MapUkv mp{ka->in[7] + (size_t)ly * 256 * 768}; conv_item(mp, 256, (bf16_t*)(wl + W_UKV), scr, r, 24, ka->in[6] + ly * 256); return; } r -= CI_UKV;
    if (r < CI_O) { MapId mp{ka->in[9] + (size_t)ly * D * D, D}; conv_item(mp, 1024, (bf16_t*)(wl + W_O), scr, r, 32); return; } r -= CI_O;
    if (r < CI_GU) { MapGu mp{ka->in[11] + (size_t)ly * D * DFF, ka->in[12] + (size_t)ly * D * DFF}; conv_item(mp, 1024, (bf16_t*)(wl + W_GU), scr, r, 176, ka->in[10] + ly * D); return; } r -= CI_GU;
    if (r < CI_DN) { MapId mp{ka->in[13] + (size_t)ly * DFF * D, D}; conv_item(mp, 2816, (bf16_t*)(wl + W_DN), scr, r, 32); return; } r -= CI_DN;
    if (r < CI_PG) { MapId mp{ka->in[15] + (size_t)ly * D * D, D}; conv_item(mp, 1024, (bf16_t*)(wl + W_PG), scr, r, 32, ka->in[14] + ly * D); return; } r -= CI_PG;
    { MapId mp{ka->in[16] + (size_t)ly * PLE * D, D}; conv_item(mp, 256, (bf16_t*)(wl + W_PP), scr, r, 32); }
}
__global__ void __launch_bounds__(NTHREADS, 2) mk_fwd(Args a_unused) {
    extern __shared__ __attribute__((aligned(16))) unsigned char lds_raw[];
    LAS unsigned char* L = (LAS unsigned char*)lds_raw;
    const int tid = threadIdx.x, lane = tid & 63, wid = __builtin_amdgcn_readfirstlane(tid >> 6);
    const int G = gridDim.x, bx = blockIdx.x;
    const int gw = bx * NWAVES + wid, ngw = G * NWAVES;
    volatile LAS unsigned* MISC = (volatile LAS unsigned*)(L + L_MISC);
    for (int u = tid; u < (LDS_BYTES - L_PRM) / 4; u += NTHREADS) ((LAS unsigned*)(L + L_PRM))[u] = 0u;
    {
        KARGS(ka);
        LAS float* biasT = (LAS float*)(L + L_BIAS);
        const float* rel_bias = ka->in[8];
        for (int i = tid; i < 129 * 8; i += NTHREADS) { const int d = i >> 3, h = i & 7; int bucket;
            if (d < 16) bucket = d; else { bucket = 16 + (int)(logf((float)d / 16.f) / logf(8.f) * 16.f); bucket = min(bucket, 31); }
            biasT[i] = (h < 5) ? rel_bias[bucket * 5 + h] * LOG2E : 0.f; }
    }
    __syncthreads();
    XcdBarrier bar;
    { KARGS(ka); bar = xcd_barrier_post((unsigned*)(ka->ws + WS_CTL) + CW_BAR, MISC); }

    {
        KARGS(ka);
        LAS float* scr = (LAS float*)(L + L_H + wid * 16384);
        for (int it = gw; it < CONV_ITEMS; it += ngw) conv_layer_item(ka, 0, it, scr);
    }
    { KARGS(ka); x_to_h_rows(ka->in[0], (bf16_t*)(ka->ws + WS_HA), (float*)(ka->ws + WS_SS + 2 * SS_BYTES), gw, ngw); }
    xcd_barrier(bar);

    for (int ly = 0; ly < DEPTH; ++ly) {
#define HCUR(ka) ((bf16_t*)((ly & 1) ? (unsigned char*)(ka)->out : (ka)->ws + WS_HA))
#define HNXT(ka) ((bf16_t*)((ly & 1) ? (ka)->ws + WS_HA : (unsigned char*)(ka)->out))
#define MIXB(ka) ((bf16_t*)((unsigned char*)(ka)->out + (size_t)M * D * 2))
#define SSP(ka, i) ((float*)((ka)->ws + WS_SS + (size_t)(i) * SS_BYTES))
        { KARGS(ka); unsigned char* ws = ka->ws; const unsigned char* wl = ws + WS_W + (size_t)ly * LAYER_W_BYTES;
          pg8::Gemm g{HCUR(ka), (const bf16_t*)(wl + W_IN), M, NP, 1024, 1024, 1024}; pg8::StaticOrder S; S.init(M, NP, G, bx);
          pg8::EpiInProj E{(bf16_t*)(ws + WS_P), SSP(ka, 2), (float*)(ws + WS_SSN), (bf16_t*)(ws + WS_KR), (bf16_t*)(ws + WS_IKC), (bf16_t*)(ws + WS_DKV), (unsigned*)(ws + WS_CTL) + CW_KMAX + 64 * 4 * ly};
          for (int rep = 0; rep < REP_GEMM; ++rep) pg8::gemm_phase(L + L_H, g, S, E);
          const int nfull = ((M / 256) * (NP / 256)) % G;
          if (nfull == 0) cvt_p_rows(ka->in[1] + (size_t)ly * M * PLE, (bf16_t*)(ws + WS_PB), bx * NTHREADS, G * NTHREADS);
          else if (bx >= nfull) cvt_p_rows(ka->in[1] + (size_t)ly * M * PLE, (bf16_t*)(ws + WS_PB), (bx - nfull) * NTHREADS, (G - nfull) * NTHREADS); }
        xcd_barrier(bar);
        { KARGS(ka); unsigned char* ws = ka->ws; const unsigned char* wl = ws + WS_W + (size_t)ly * LAYER_W_BYTES;
          pg8::Gemm g{(const bf16_t*)(ws + WS_P) + C_CQ, (const bf16_t*)(wl + W_UQ), M, 768, 384, NP, 384}; pg8::StaticOrder S; S.init(M, 768, G, bx);
          pg8::EpiUq E{(bf16_t*)(ws + WS_QM), (const float*)(ws + WS_SSN)}; pg8::gemm_phase(L + L_H, g, S, E); }
        { KARGS(ka); unsigned char* ws = ka->ws; const unsigned char* wl = ws + WS_W + (size_t)ly * LAYER_W_BYTES;
          pg8::Gemm g{(const bf16_t*)(ws + WS_P) + C_CKV, (const bf16_t*)(wl + W_UKV), M, 768, 256, NP, 256}; pg8::StaticOrder S; S.init(M, 768, G, (bx + G / 2) % G);
          pg8::EpiBf16 E{(bf16_t*)(ws + WS_KV), KV_LD, KV_LD, (const float*)(ws + WS_SSN), 2}; pg8::gemm_phase(L + L_H, g, S, E); }
        xcd_barrier(bar);
        {
            for (;;) {
                KARGS(ka); unsigned char* ws = ka->ws;
                if (tid == 0) MISC[4] = atomicAdd((unsigned*)(ws + WS_CTL) + CW_Q + 64 * ly, 1u);
                __syncthreads();
                const int u = (int)MISC[4];
                __syncthreads();
                if (u >= N_ATT + ((ly + 1 < DEPTH) ? N_CONVU : 0)) break;
                if (u >= N_ATT) {
                    LAS float* scr = (LAS float*)(L + L_H + wid * 16384);
                    for (int j = 0; j < CONV_PER_UNIT / NWAVES; ++j) { const int it = (u - N_ATT) * CONV_PER_UNIT + j * NWAVES + wid; if (it < CONV_ITEMS) conv_layer_item(ka, ly + 1, it, scr); }
                    __syncthreads();
                }
                else if (u < N_MLA) { const int qt = 31 - u / 24, bh = u % 24; for (int rep = 0; rep < REP_MLA; ++rep) mla_unit(L + L_H, (const bf16_t*)(ws + WS_QM), (const bf16_t*)(ws + WS_KV), (const bf16_t*)(ws + WS_KR), MIXB(ka), bh / 6, bh % 6, qt); }
                else if (u < N_MLA + N_DSA) { const int v = u - N_MLA; for (int rep = 0; rep < REP_DSA; ++rep) dsa_unit(L, (const bf16_t*)(ws + WS_P), (const bf16_t*)(ws + WS_IKC), (const bf16_t*)(ws + WS_DKV), MIXB(ka), (const unsigned*)(ws + WS_CTL) + CW_KMAX + 64 * 4 * ly, v & 3, 255 - (v >> 2)); }
                else { const int v = u - N_MLA - N_DSA; const int h = v % 5, r = v / 5; for (int rep = 0; rep < REP_SB; ++rep) { sb_unit(L + L_H, (const bf16_t*)(ws + WS_P), MIXB(ka), r & 3, r >> 2, h); __syncthreads(); } }
            }
        }
        xcd_barrier(bar);
        { KARGS(ka); unsigned char* ws = ka->ws; const unsigned char* wl = ws + WS_W + (size_t)ly * LAYER_W_BYTES;
          pg8::Gemm g{MIXB(ka), (const bf16_t*)(wl + W_O), M, D, 1024, 1024, 1024}; pg8::StaticOrder S; S.init(M, D, G, bx);
          pg8::EpiResid E{HCUR(ka), SSP(ka, 0)}; pg8::gemm_phase(L + L_H, g, S, E); }
        xcd_barrier(bar);
        { KARGS(ka); unsigned char* ws = ka->ws; const unsigned char* wl = ws + WS_W + (size_t)ly * LAYER_W_BYTES;
          pg8::Gemm g{HCUR(ka), (const bf16_t*)(wl + W_GU), M, 2 * DFF, 1024, 1024, 1024}; pg8::StaticOrder S; S.init(M, 2 * DFF, G, bx);
          pg8::EpiSwiglu E{(bf16_t*)(ws + WS_ACT), SSP(ka, 0)}; for (int rep = 0; rep < REP_GEMM; ++rep) pg8::gemm_phase(L + L_H, g, S, E); }
        { KARGS(ka); unsigned char* ws = ka->ws; const unsigned char* wl = ws + WS_W + (size_t)ly * LAYER_W_BYTES;
          pg8::Gemm g{(const bf16_t*)(ws + WS_PB), (const bf16_t*)(wl + W_PP), M, D, 256, 256, 256}; pg8::StaticOrder S; S.init(M, D, G, bx);
          pg8::EpiBf16 E{(bf16_t*)(ws + WS_PP), D, D, nullptr, 0}; pg8::gemm_phase(L + L_H, g, S, E); }
        xcd_barrier(bar);
        { KARGS(ka); unsigned char* ws = ka->ws; const unsigned char* wl = ws + WS_W + (size_t)ly * LAYER_W_BYTES;
          pg8::Gemm g{(const bf16_t*)(ws + WS_ACT), (const bf16_t*)(wl + W_DN), M, D, DFF, DFF, DFF}; pg8::StaticOrder S; S.init(M, D, G, bx);
          pg8::EpiResid E{HCUR(ka), SSP(ka, 1)}; pg8::gemm_phase(L + L_H, g, S, E); }
        xcd_barrier(bar);
        { KARGS(ka); unsigned char* ws = ka->ws; const unsigned char* wl = ws + WS_W + (size_t)ly * LAYER_W_BYTES;
          pg8::Gemm g{HCUR(ka), (const bf16_t*)(wl + W_PG), M, D, 1024, 1024, 1024}; pg8::StaticOrder S; S.init(M, D, G, bx);
          pg8::EpiPle E{HCUR(ka), HNXT(ka), (const bf16_t*)(ws + WS_PP), SSP(ka, 1), SSP(ka, 2)}; pg8::gemm_phase(L + L_H, g, S, E); }
        xcd_barrier(bar);
    }
    { KARGS(ka); final_norm_rows((const bf16_t*)(ka->ws + WS_HA), ka->in[17], ka->out, gw, ngw); }
}

extern "C" void kernel_launch(void* const* d_in, const int* in_sizes, int n_in, void* d_out, int out_size, void* d_ws, size_t ws_size, hipStream_t stream) {
    static int grid = 0;
    if (grid == 0) {
        if (n_in != 18 || out_size != M * D || ws_size < WS_END) { fprintf(stderr, "kernel_launch: unexpected shapes (n_in %d, out %d, ws %zu); nothing launched\n", n_in, out_size, ws_size); grid = -1; return; }
        int dev = 0, cus = 0, per_cu = 0;
        if (hipGetDevice(&dev) != hipSuccess || hipDeviceGetAttribute(&cus, hipDeviceAttributeMultiprocessorCount, dev) != hipSuccess) { grid = -1; return; }
        if (hipFuncSetAttribute((const void*)mk_fwd, hipFuncAttributeMaxDynamicSharedMemorySize, LDS_BYTES) != hipSuccess) { fprintf(stderr, "kernel_launch: hipFuncSetAttribute failed\n"); grid = -1; return; }
        if (hipOccupancyMaxActiveBlocksPerMultiprocessor(&per_cu, (const void*)mk_fwd, NTHREADS, LDS_BYTES) != hipSuccess || per_cu < 1) { fprintf(stderr, "kernel_launch: occupancy query says %d\n", per_cu); }
        (void)hipGetLastError();
        grid = cus;
    }
    if (grid < 0) return;
    if (hipMemsetAsync((char*)d_ws + WS_CTL, 0, CTL_ZERO_BYTES, stream) != hipSuccess) return;
    Args a{};
    for (int i = 0; i < 18; ++i) a.in[i] = (const float*)d_in[i];
    a.out = (float*)d_out; a.ws = (unsigned char*)d_ws;
    hipLaunchKernelGGL(mk_fwd, dim3(grid), dim3(NTHREADS), LDS_BYTES, stream, a);
}
```

```cpp
#include <hip/hip_runtime.h>
#include <cstdio>
#include <cstdint>

#ifndef PH
#define PH 0xFFFF
#endif
#ifndef REP_MLA
#define REP_MLA 1
#endif
#ifndef REP_DSA
#define REP_DSA 1
#endif
#ifndef REP_SB
#define REP_SB 1
#endif
#ifndef REP_GEMM
#define REP_GEMM 1
#endif
#ifndef REP_ROW
#define REP_ROW 1
#endif
#ifndef REP_DSEL
#define REP_DSEL 1
#endif
#ifndef REP_DATT
#define REP_DATT 1
#endif
#ifndef PROBE_DRY
#define PROBE_DRY 0
#endif
#ifndef PROBE_BAR
#define PROBE_BAR 0
#endif
#ifndef REP_ATTPH
#define REP_ATTPH 1
#endif
#ifndef REP_INPH
#define REP_INPH 1
#endif
#ifndef REP_PREPPH
#define REP_PREPPH 1
#endif
#ifndef REP_UQPH
#define REP_UQPH 1
#endif
#ifndef REP_GUPH
#define REP_GUPH 1
#endif
#ifndef REP_CONV
#define REP_CONV 1
#endif
#ifndef REP_RANK
#define REP_RANK 1
#endif
#ifndef REP_LIST
#define REP_LIST 1
#endif
#ifndef PROBE_HIST
#define PROBE_HIST 0
#endif
#ifndef PROBE_ZERO
#define PROBE_ZERO 0
#endif

#define LAS __attribute__((address_space(3)))
#define GAS __attribute__((address_space(1)))
typedef unsigned short bf16_t;
typedef short bf16x8 __attribute__((ext_vector_type(8)));
typedef short s16x4 __attribute__((ext_vector_type(4)));
typedef float f32x2 __attribute__((ext_vector_type(2)));
typedef float f32x4 __attribute__((ext_vector_type(4)));
typedef float f32x16 __attribute__((ext_vector_type(16)));
typedef unsigned u32x2 __attribute__((ext_vector_type(2)));
typedef unsigned u32x4 __attribute__((ext_vector_type(4)));
typedef __bf16 bf16x2_t __attribute__((ext_vector_type(2)));

constexpr int SEQ = 8192, NBATCH = 4, M = NBATCH * SEQ, D = 1024, DEPTH = 4, DFF = 2816, PLE = 256, DIN = 2664;
constexpr int NP = 2816;
constexpr float EPS = 1e-6f, LOG2E = 1.4426950408889634f;
constexpr int C_CQ = 0, C_CKV = 384, C_KR = 640, C_IW = 672, C_DQ = 704, C_DK = 1024, C_DV = 1088, C_IQ = 1152, C_IK = 1664, C_SQ = 1728, C_SK = 2048, C_SV = 2368;
constexpr int QM_LD = 576, KV_LD = 768, CQN_LD = 640;
constexpr size_t MiB = 1u << 20;
constexpr size_t WS_CTL = 0, CTL_ZERO_BYTES = 1 * MiB;
constexpr size_t W_IN = 0, W_UQ = 5767168, W_UKV = 6356992, W_O = 6750208, W_GU = 8847360, W_DN = 20381696, W_PG = 26148864, W_PP = 28246016, LAYER_W_BYTES = 28770304;
constexpr size_t WS_W = 1 * MiB;
constexpr size_t WS_HA = 112 * MiB, WS_P = 176 * MiB, WS_QM = 352 * MiB, WS_KV = 388 * MiB, WS_KR = 436 * MiB, WS_CQN = 438 * MiB, WS_SSN = 438 * MiB, WS_IKC = 478 * MiB, WS_DKV = 482 * MiB, WS_PB = 490 * MiB, WS_SS = 506 * MiB, WS_END = 512 * MiB;
constexpr size_t WS_ACT = WS_P, WS_PP = WS_KV;
constexpr size_t SS_BYTES = (size_t)M * 16 * 4;
static_assert(WS_W + DEPTH * LAYER_W_BYTES <= WS_HA && WS_SS + 3 * SS_BYTES <= WS_END, "workspace map");
constexpr int CW_BAR = 4096, CW_Q = 8192, CW_KMAX = 9216;
constexpr int L_H = 0, L_SEL = 131072, L_BIAS = 147456, L_PRM = 151680, L_MISC = 155776, LDS_BYTES = 156160;
constexpr int NWAVES = 8, NTHREADS = 512;

__device__ __forceinline__ unsigned pk_bf16(float lo, float hi) { f32x2 v = {lo, hi}; bf16x2_t b = __builtin_convertvector(v, bf16x2_t); return __builtin_bit_cast(unsigned, b); }
__device__ __forceinline__ float bf_lo(unsigned u) { return __uint_as_float(u << 16); }
__device__ __forceinline__ float bf_hi(unsigned u) { return __uint_as_float(u & 0xffff0000u); }
__device__ __forceinline__ float wave_sum(float v) {
#pragma unroll
    for (int o = 1; o < 64; o <<= 1) v += __shfl_xor(v, o);
    return v;
}
__device__ __forceinline__ void rope_coef(int i, float& c_hi, float& c_lo) { const float c = exp2f(-(float)i * 0.83048202372184f) * 0.15915494309189535f; c_hi = __uint_as_float(__float_as_uint(c) & 0xFFFFE000u); c_lo = c - c_hi; }
__device__ __forceinline__ void rope_sc(float pos, float c_hi, float c_lo, float& sn, float& cs) { const float rev = __builtin_amdgcn_fractf(pos * c_hi) + pos * c_lo; sn = __builtin_amdgcn_sinf(rev); cs = __builtin_amdgcn_cosf(rev); }
__device__ __forceinline__ float relu_i(float x) { return __builtin_bit_cast(float, max(__builtin_bit_cast(int, x), 0)); }
__device__ __forceinline__ int opaque_tid() { int t = threadIdx.x; asm volatile("" : "+v"(t)); return t; }
__device__ __forceinline__ u32x4 opaque_splat(unsigned v) { asm volatile("" : "+v"(v)); return (u32x4){v, v, v, v}; }
__device__ __forceinline__ int crow(int r, int hi) { return (r & 3) + 8 * (r >> 2) + 4 * hi; }
__device__ __forceinline__ f32x16 mfma32(bf16x8 a, bf16x8 b, f32x16 c) { return __builtin_amdgcn_mfma_f32_32x32x16_bf16(a, b, c, 0, 0, 0); }
__device__ __forceinline__ f32x4 mfma16(bf16x8 a, bf16x8 b, f32x4 c) { return __builtin_amdgcn_mfma_f32_16x16x32_bf16(a, b, c, 0, 0, 0); }
typedef short v4i16_t __attribute__((ext_vector_type(4)));
__device__ __forceinline__ s16x4 ldtr(LAS const unsigned char* p) { return __builtin_bit_cast(s16x4, __builtin_amdgcn_ds_read_tr16_b64_v4i16((LAS v4i16_t*)p)); }
__device__ __forceinline__ bf16x8 cat8(s16x4 a, s16x4 b) { return (bf16x8){a[0], a[1], a[2], a[3], b[0], b[1], b[2], b[3]}; }
__device__ __forceinline__ bf16x8 pack8(float a0, float a1, float a2, float a3, float a4, float a5, float a6, float a7) {
    u32x4 w; w.x = pk_bf16(a0, a1); w.y = pk_bf16(a2, a3); w.z = pk_bf16(a4, a5); w.w = pk_bf16(a6, a7); return __builtin_bit_cast(bf16x8, w);
}

namespace pg8 {
constexpr int BM = 256, BK = 64, HALF = 128, HTB = HALF * BK * 2, NXCD = 8, WGM = 8;
__host__ __device__ __forceinline__ int lds_byte(int r, int c) { const int st = (r >> 4) * 2 + (c >> 5), rr = r & 15, cc = c & 31, ob = rr * 64 + cc * 2; return st * 1024 + (ob ^ (((ob >> 9) & 1) << 5)); }
__host__ __device__ __forceinline__ void stage_rc(int b, int& R, int& C) { const int st = b / 1024, sb = b % 1024, swz = sb ^ (((sb >> 9) & 1) << 5); R = (st >> 1) * 16 + swz / 64; C = (st & 1) * 32 + (swz % 64) / 2; }
__host__ __device__ __forceinline__ int perm32(int rho) { const int n = rho >> 4, i = rho & 15; return 8 * (i >> 2) + 4 * n + (i & 3); }
struct Unit { int pm, pn; };
struct Gemm { const bf16_t* A; const bf16_t* Bt; int M, N, K, lda, ldb; };
struct StaticOrder {
    int nM, nN, nwg, G, c;
    __device__ void init(int M_, int N_, int G_, int c_) { nM = M_ / BM; nN = N_ / BM; nwg = nM * nN; G = G_; c = c_; }
    __device__ bool next(int i, Unit& u) const {
        const long L = (long)i * G + c; if (L >= nwg) return false;
        int wgid = (int)L; { const int q = nwg / NXCD, r = nwg % NXCD, xcd = wgid % NXCD, off = wgid / NXCD; wgid = (xcd < r ? xcd * (q + 1) : r * (q + 1) + (xcd - r) * q) + off; }
        const int nig = WGM * nN, gid = wgid / nig, fm = gid * WGM, gsz = (nM - fm) < WGM ? (nM - fm) : WGM;
        u.pm = fm + ((wgid % nig) % gsz); u.pn = (wgid % nig) / gsz; return true;
    }
};

template <class Epi>
__device__ __forceinline__ void gemm_phase(LAS unsigned char* lds, const Gemm g, const StaticOrder& S, const Epi& E) {
    const int tid = opaque_tid(), wid = __builtin_amdgcn_readfirstlane(tid >> 6), lane = tid & 63, wr = wid >> 2, wc = wid & 3, fr = lane & 15, fq = lane >> 4;
    const int K = g.K, nt = K / BK;
    unsigned voffA[2], voffB[2];
#pragma unroll
    for (int i = 0; i < 2; ++i) { int R, C; stage_rc(tid * 16 + i * 8192, R, C); const int Rb = (R & ~31) + perm32(R & 31);
        voffA[i] = (unsigned)(R * g.lda + C) * 2u; voffB[i] = (unsigned)(Rb * g.ldb + C) * 2u; }
    const size_t kstep = (size_t)(BK * 2);
    const size_t hstepA = (size_t)HALF * g.lda * 2, hstepB = (size_t)HALF * g.ldb * 2;
    const size_t tstepA = 2 * hstepA, tstepB = 2 * hstepB;
    const unsigned ldsw = (unsigned)wid * 1024u;
    const int aoff = lds_byte(wr * 64 + fr, fq * 8), boff = lds_byte(wc * 32 + fr, fq * 8);
#define PG8_SA(b, h) (((b) * 2 + (h)) * HTB)
#define PG8_SB(b, h) ((4 + (b) * 2 + (h)) * HTB)
#define PG8_STAGE(bufoff, gbase, voff) do { _Pragma("unroll") for (int _i = 0; _i < 2; ++_i) \
        __builtin_amdgcn_global_load_lds((const unsigned*)((const char*)(gbase) + (voff)[_i]), (LAS unsigned*)(lds + (bufoff) + ldsw + _i * 8192), 16, 0, 0); } while (0)
#define PG8_LDA(dst, b, h) do { _Pragma("unroll") for (int m = 0; m < 4; ++m) _Pragma("unroll") for (int k = 0; k < 2; ++k) dst[m][k] = *(const LAS bf16x8*)(lds + PG8_SA(b, h) + aoff + m * 2048 + k * 1024); } while (0)
#define PG8_LDB(dst, b, h) do { _Pragma("unroll") for (int n = 0; n < 2; ++n) _Pragma("unroll") for (int k = 0; k < 2; ++k) dst[n][k] = *(const LAS bf16x8*)(lds + PG8_SB(b, h) + boff + n * 2048 + k * 1024); } while (0)
#define PG8_MMA(ai, bj, At, Bt) do { __builtin_amdgcn_s_setprio(1); _Pragma("unroll") for (int m = 0; m < 4; ++m) _Pragma("unroll") for (int n = 0; n < 2; ++n) _Pragma("unroll") for (int k = 0; k < 2; ++k) \
        acc[ai][bj][m][n] = __builtin_amdgcn_mfma_f32_16x16x32_bf16(Bt[n][k], At[m][k], acc[ai][bj][m][n], 0, 0, 0); __builtin_amdgcn_s_setprio(0); } while (0)
#define PG8_WAIT_V(n) asm volatile("s_waitcnt vmcnt(" #n ")" ::: "memory")
#define PG8_WAIT_L(n) asm volatile("s_waitcnt lgkmcnt(" #n ")" ::: "memory")
#define PG8_BAR __builtin_amdgcn_s_barrier()
#define PG8_SCHED __builtin_amdgcn_sched_barrier(0)
    Unit cur, nxt; int ui = 0;
    if (!S.next(0, cur)) return;
    f32x4 acc[2][2][4][2];
#pragma unroll
    for (int a = 0; a < 2; ++a)
#pragma unroll
        for (int b = 0; b < 2; ++b)
#pragma unroll
            for (int m = 0; m < 4; ++m)
#pragma unroll
                for (int n = 0; n < 2; ++n) acc[a][b][m][n] = (f32x4){0.f, 0.f, 0.f, 0.f};
    bf16x8 At[4][2], B0[2][2], B1[2][2];
    const char* cA = (const char*)g.A + (size_t)cur.pm * tstepA; const char* cB = (const char*)g.Bt + (size_t)cur.pn * tstepB;
    PG8_STAGE(PG8_SB(0, 0), cB, voffB); PG8_STAGE(PG8_SB(0, 1), cB + hstepB, voffB); PG8_STAGE(PG8_SA(0, 0), cA, voffA); PG8_STAGE(PG8_SA(0, 1), cA + hstepA, voffA);
    if (wr == 1) PG8_BAR;
    PG8_WAIT_V(2); PG8_BAR;
    PG8_STAGE(PG8_SB(1, 0), cB + kstep, voffB); PG8_STAGE(PG8_SA(1, 0), cA + kstep, voffA); PG8_STAGE(PG8_SB(1, 1), cB + hstepB + kstep, voffB);
    PG8_WAIT_V(6); PG8_BAR;
    for (;;) {
        const bool has_next = S.next(ui + 1, nxt);
        const char* nA = has_next ? (const char*)g.A + (size_t)nxt.pm * tstepA : cA; const char* nB = has_next ? (const char*)g.Bt + (size_t)nxt.pn * tstepB : cB;
#pragma unroll 1
        for (int t = 0; t < nt; t += 2) {
            const bool last = (t == nt - 2);
            const char* a1 = cA + (size_t)(t + 1) * kstep;
            const char* a2 = last ? nA : cA + (size_t)(t + 2) * kstep; const char* b2 = last ? nB : cB + (size_t)(t + 2) * kstep;
            const char* a3 = a2 + kstep; const char* b3 = b2 + kstep;
            PG8_LDB(B0, 0, 0); PG8_LDB(B1, 0, 1); PG8_SCHED; PG8_LDA(At, 0, 0); PG8_STAGE(PG8_SA(1, 1), a1 + hstepA, voffA);
            PG8_WAIT_V(8); PG8_WAIT_L(0); PG8_BAR; PG8_MMA(0, 0, At, B0); PG8_MMA(0, 1, At, B1); PG8_BAR; PG8_SCHED;
            PG8_LDA(At, 0, 1); PG8_STAGE(PG8_SB(0, 0), b2, voffB); PG8_STAGE(PG8_SB(0, 1), b2 + hstepB, voffB); PG8_STAGE(PG8_SA(0, 0), a2, voffA);
            PG8_WAIT_V(8); PG8_WAIT_L(0); PG8_BAR; PG8_MMA(1, 0, At, B0); PG8_MMA(1, 1, At, B1); PG8_BAR; PG8_SCHED;
            PG8_LDB(B0, 1, 0); PG8_LDB(B1, 1, 1); PG8_SCHED; PG8_LDA(At, 1, 0); PG8_STAGE(PG8_SA(0, 1), a2 + hstepA, voffA);
            PG8_WAIT_V(8); PG8_WAIT_L(0); PG8_BAR; PG8_MMA(0, 0, At, B0); PG8_MMA(0, 1, At, B1); PG8_BAR; PG8_SCHED;
            PG8_LDA(At, 1, 1); PG8_STAGE(PG8_SB(1, 0), b3, voffB); PG8_STAGE(PG8_SB(1, 1), b3 + hstepB, voffB); PG8_STAGE(PG8_SA(1, 0), a3, voffA);
            PG8_WAIT_V(8); PG8_WAIT_L(0); PG8_BAR; PG8_MMA(1, 0, At, B0); PG8_MMA(1, 1, At, B1); PG8_BAR; PG8_SCHED;
        }
        if (wr == 0) PG8_BAR;
        E(acc, cur, wr, wc, fr, fq);
        if (!has_next) break;
#pragma unroll
        for (int a = 0; a < 2; ++a)
#pragma unroll
            for (int b = 0; b < 2; ++b)
#pragma unroll
                for (int m = 0; m < 4; ++m)
#pragma unroll
                    for (int n = 0; n < 2; ++n) acc[a][b][m][n] = (f32x4){0.f, 0.f, 0.f, 0.f};
        cur = nxt; cA = nA; cB = nB; ++ui;
        if (wr == 1) PG8_BAR;
    }
    PG8_WAIT_V(0);
    PG8_BAR;
#undef PG8_SA
#undef PG8_SB
#undef PG8_STAGE
#undef PG8_LDA
#undef PG8_LDB
#undef PG8_MMA
#undef PG8_WAIT_V
#undef PG8_WAIT_L
#undef PG8_BAR
#undef PG8_SCHED
}

typedef const f32x4 (&AccRef)[2][2][4][2];
__device__ __forceinline__ float row_rstd(const float* ss, int row) {
    const f32x4* p = (const f32x4*)(ss + (size_t)row * 16); const f32x4 a = p[0], b = p[1], c = p[2], d = p[3];
    const float t = ((a[0] + a[1]) + (a[2] + a[3])) + ((b[0] + b[1]) + (b[2] + b[3])) + ((c[0] + c[1]) + (c[2] + c[3])) + ((d[0] + d[1]) + (d[2] + d[3]));
    return rsqrtf(t * (1.f / D) + EPS);
}
constexpr int SSN_LD = 32;
__device__ __forceinline__ float row_rstd_q(const float* ssn, int row) {
    const f32x4* p = (const f32x4*)(ssn + (size_t)row * SSN_LD); const f32x4 a = p[0], b = p[1], c = p[2];
    const float t = ((a[0] + a[1]) + (a[2] + a[3])) + ((b[0] + b[1]) + (b[2] + b[3])) + ((c[0] + c[1]) + (c[2] + c[3]));
    return rsqrtf(t * (1.f / 384.f) + EPS);
}
__device__ __forceinline__ float row_rstd_kv(const float* ssn, int row) {
    const f32x4* p = (const f32x4*)(ssn + (size_t)row * SSN_LD + 12); const f32x4 a = p[0], b = p[1];
    const float t = ((a[0] + a[1]) + (a[2] + a[3])) + ((b[0] + b[1]) + (b[2] + b[3]));
    return rsqrtf(t * (1.f / 256.f) + EPS);
}
template <int MODE>
__device__ __forceinline__ void rstd8(const float* ss, int row0, int fq, float (&rs)[8]) {
    f32x4 p[8];
#pragma unroll
    for (int i = 0; i < 8; ++i) { const int row = row0 + (i >> 2) * HALF + (i & 3) * 16; p[i] = (f32x4){0.f, 0.f, 0.f, 0.f};
        if (MODE == 1) p[i] = *(const f32x4*)(ss + (size_t)row * 16 + 4 * fq);
        else if (MODE == 2) p[i] = *(const f32x4*)(ss + (size_t)row * SSN_LD + 4 * min(fq, 2));
        else p[i] = *(const f32x4*)(ss + (size_t)row * SSN_LD + 12 + 4 * (fq & 1)); }
    __builtin_amdgcn_sched_barrier(0);
#pragma unroll
    for (int i = 0; i < 8; ++i) { float t = (p[i][0] + p[i][1]) + (p[i][2] + p[i][3]); if (MODE == 2) t = (fq < 3) ? t : 0.f; if (MODE == 3) t = (fq < 2) ? t : 0.f;
        t += __shfl_xor(t, 16); t += __shfl_xor(t, 32);
        rs[i] = rsqrtf(t * (MODE == 1 ? 1.f / D : MODE == 2 ? 1.f / 384.f : 1.f / 256.f) + EPS); }
}
struct EpiBf16 {
    bf16_t* O; int ldc; int ncols; const float* ss; int mode;
    __device__ __forceinline__ void operator()(AccRef acc, const Unit& u, int wr, int wc, int fr, int fq) const {
        const int row0 = u.pm * BM + wr * 64 + fr;
        float rs8[8];
        if (mode == 2) rstd8<3>(ss, row0, fq, rs8); else {
#pragma unroll
            for (int i = 0; i < 8; ++i) rs8[i] = 1.f; }
#pragma unroll
        for (int ai = 0; ai < 2; ++ai)
#pragma unroll
            for (int m = 0; m < 4; ++m) { const int row = row0 + ai * HALF + m * 16; const float rs = rs8[4 * ai + m];
#pragma unroll
                for (int bj = 0; bj < 2; ++bj) { const int col0 = u.pn * BM + bj * HALF + wc * 32 + 8 * fq; if (col0 >= ncols) continue;
                    const f32x4 v0 = acc[ai][bj][m][0] * rs, v1 = acc[ai][bj][m][1] * rs;
                    u32x4 w; w.x = pk_bf16(v0[0], v0[1]); w.y = pk_bf16(v0[2], v0[3]); w.z = pk_bf16(v1[0], v1[1]); w.w = pk_bf16(v1[2], v1[3]);
                    *(u32x4*)(O + (size_t)row * ldc + col0) = w; } }
    }
};
struct EpiUq {
    bf16_t* O; const float* ssn;
    __device__ __forceinline__ void operator()(AccRef acc, const Unit& u, int wr, int wc, int fr, int fq) const {
        const int row0 = u.pm * BM + wr * 64 + fr;
        float rs8[8]; rstd8<2>(ssn, row0, fq, rs8);
#pragma unroll
        for (int bj = 0; bj < 2; ++bj) { const int col0 = u.pn * BM + bj * HALF + wc * 32 + 8 * fq; if (col0 >= QM_LD) continue;
            const int w = col0 % 96; const bool rope = w >= 64; const int i0 = (w - 64) >> 1;
            float ch[4], cl[4];
#pragma unroll
            for (int p = 0; p < 4; ++p) rope_coef(i0 + p, ch[p], cl[p]);
#pragma unroll
            for (int ai = 0; ai < 2; ++ai)
#pragma unroll
                for (int m = 0; m < 4; ++m) { const int row = row0 + ai * HALF + m * 16; const float rs = rs8[4 * ai + m]; f32x4 v0 = acc[ai][bj][m][0] * rs, v1 = acc[ai][bj][m][1] * rs;
                    if (rope) { const float pos = (float)(row & (SEQ - 1));
                        float s, c;
                        rope_sc(pos, ch[0], cl[0], s, c); { const float x1 = v0[0], x2 = v0[1]; v0[0] = x1 * c - x2 * s; v0[1] = x1 * s + x2 * c; }
                        rope_sc(pos, ch[1], cl[1], s, c); { const float x1 = v0[2], x2 = v0[3]; v0[2] = x1 * c - x2 * s; v0[3] = x1 * s + x2 * c; }
                        rope_sc(pos, ch[2], cl[2], s, c); { const float x1 = v1[0], x2 = v1[1]; v1[0] = x1 * c - x2 * s; v1[1] = x1 * s + x2 * c; }
                        rope_sc(pos, ch[3], cl[3], s, c); { const float x1 = v1[2], x2 = v1[3]; v1[2] = x1 * c - x2 * s; v1[3] = x1 * s + x2 * c; } }
                    u32x4 wv; wv.x = pk_bf16(v0[0], v0[1]); wv.y = pk_bf16(v0[2], v0[3]); wv.z = pk_bf16(v1[0], v1[1]); wv.w = pk_bf16(v1[2], v1[3]);
                    *(u32x4*)(O + (size_t)row * QM_LD + col0) = wv; } }
    }
};
__device__ __forceinline__ float sq8(const u32x4 w) { return (bf_lo(w.x) * bf_lo(w.x) + bf_hi(w.x) * bf_hi(w.x)) + (bf_lo(w.y) * bf_lo(w.y) + bf_hi(w.y) * bf_hi(w.y)) + (bf_lo(w.z) * bf_lo(w.z) + bf_hi(w.z) * bf_hi(w.z)) + (bf_lo(w.w) * bf_lo(w.w) + bf_hi(w.w) * bf_hi(w.w)); }
struct EpiInProj {
    bf16_t* O; const float* ss; float* SSn; bf16_t* KR; bf16_t* IKC; bf16_t* DKV; unsigned* kmaxw;
    __device__ __forceinline__ void operator()(AccRef acc, const Unit& u, int wr, int wc, int fr, int fq) const {
        const int row0 = u.pm * BM + wr * 64 + fr, slab0 = u.pn * 8 + wc;
        float ch[4], cl[4];
        if (slab0 + 4 == 20) {
#pragma unroll
            for (int p = 0; p < 4; ++p) rope_coef(4 * fq + p, ch[p], cl[p]); }
        float kmx = 0.f;
        float rs8[8]; rstd8<1>(ss, row0, fq, rs8);
#pragma unroll
        for (int ai = 0; ai < 2; ++ai)
#pragma unroll
            for (int m = 0; m < 4; ++m) { const int row = row0 + ai * HALF + m * 16; const float rs = rs8[4 * ai + m];
#pragma unroll
                for (int bj = 0; bj < 2; ++bj) { const int slab = slab0 + 4 * bj, col0 = slab * 32 + 8 * fq; if (slab >= 84) continue;
                    f32x4 v0 = acc[ai][bj][m][0] * rs, v1 = acc[ai][bj][m][1] * rs;
                    u32x4 w; w.x = pk_bf16(v0[0], v0[1]); w.y = pk_bf16(v0[2], v0[3]); w.z = pk_bf16(v1[0], v1[1]); w.w = pk_bf16(v1[2], v1[3]);
                    *(u32x4*)(O + (size_t)row * NP + col0) = w;
                    if (slab < 20) { float sq = sq8(w); sq += __shfl_xor(sq, 16); sq += __shfl_xor(sq, 32); if (fq == 0) SSn[(size_t)row * SSN_LD + slab] = sq; }
                    else if (slab == 20) { const float pos = (float)(row & (SEQ - 1)); float s, c;
                        rope_sc(pos, ch[0], cl[0], s, c); { const float x1 = v0[0], x2 = v0[1]; v0[0] = x1 * c - x2 * s; v0[1] = x1 * s + x2 * c; }
                        rope_sc(pos, ch[1], cl[1], s, c); { const float x1 = v0[2], x2 = v0[3]; v0[2] = x1 * c - x2 * s; v0[3] = x1 * s + x2 * c; }
                        rope_sc(pos, ch[2], cl[2], s, c); { const float x1 = v1[0], x2 = v1[1]; v1[0] = x1 * c - x2 * s; v1[1] = x1 * s + x2 * c; }
                        rope_sc(pos, ch[3], cl[3], s, c); { const float x1 = v1[2], x2 = v1[3]; v1[2] = x1 * c - x2 * s; v1[3] = x1 * s + x2 * c; }
                        u32x4 wk; wk.x = pk_bf16(v0[0], v0[1]); wk.y = pk_bf16(v0[2], v0[3]); wk.z = pk_bf16(v1[0], v1[1]); wk.w = pk_bf16(v1[2], v1[3]);
                        *(u32x4*)(KR + (size_t)row * 32 + 8 * fq) = wk; }
                    else if (slab >= 32 && slab < 36) *(u32x4*)(DKV + (size_t)row * 128 + (slab - 32) * 32 + 8 * fq) = w;
                    else if (slab == 52 || slab == 53) { *(u32x4*)(IKC + (size_t)row * 64 + (slab - 52) * 32 + 8 * fq) = w;
                        float sq = sq8(w); sq += __shfl_xor(sq, 16); sq += __shfl_xor(sq, 32); kmx = fmaxf(kmx, sq); } } }
        if (slab0 + 4 == 52 || slab0 + 4 == 53) {
            kmx = fmaxf(kmx, __shfl_xor(kmx, 1)); kmx = fmaxf(kmx, __shfl_xor(kmx, 2)); kmx = fmaxf(kmx, __shfl_xor(kmx, 4)); kmx = fmaxf(kmx, __shfl_xor(kmx, 8));
            if (fr == 0 && fq == 0) atomicMax(kmaxw + 64 * ((u.pm * BM) / SEQ) + (slab0 + 4 - 52), __float_as_uint(kmx)); }
    }
};
struct EpiResid {
    bf16_t* H; float* SSo;
    __device__ __forceinline__ void operator()(AccRef acc, const Unit& u, int wr, int wc, int fr, int fq) const {
        const int row0 = u.pm * BM + wr * 64 + fr;
#pragma unroll
        for (int ai = 0; ai < 2; ++ai) {
            u32x4 hv[4][2];
#pragma unroll
            for (int m = 0; m < 4; ++m)
#pragma unroll
                for (int bj = 0; bj < 2; ++bj) hv[m][bj] = *(const u32x4*)(H + (size_t)(row0 + ai * HALF + m * 16) * D + u.pn * BM + bj * HALF + wc * 32 + 8 * fq);
            __builtin_amdgcn_sched_barrier(0);
#pragma unroll
            for (int m = 0; m < 4; ++m) { const int row = row0 + ai * HALF + m * 16; const size_t ro = (size_t)row * D; float sq = 0.f;
#pragma unroll
                for (int bj = 0; bj < 2; ++bj) { const int col0 = u.pn * BM + bj * HALF + wc * 32 + 8 * fq;
                    const u32x4 h4 = hv[m][bj]; const f32x4 a0 = acc[ai][bj][m][0], a1 = acc[ai][bj][m][1];
                    u32x4 w; w.x = pk_bf16(bf_lo(h4.x) + a0[0], bf_hi(h4.x) + a0[1]); w.y = pk_bf16(bf_lo(h4.y) + a0[2], bf_hi(h4.y) + a0[3]);
                    w.z = pk_bf16(bf_lo(h4.z) + a1[0], bf_hi(h4.z) + a1[1]); w.w = pk_bf16(bf_lo(h4.w) + a1[2], bf_hi(h4.w) + a1[3]);
                    *(u32x4*)(H + ro + col0) = w; sq += sq8(w); }
                sq += __shfl_xor(sq, 16); sq += __shfl_xor(sq, 32);
                if (fq == 0) SSo[(size_t)row * 16 + u.pn * 4 + wc] = sq; } }
    }
};
struct EpiSwiglu {
    bf16_t* O; const float* ss;
    __device__ __forceinline__ void operator()(AccRef acc, const Unit& u, int wr, int wc, int fr, int fq) const {
        const int row0 = u.pm * BM + wr * 64 + fr; const int col0 = u.pn * HALF + wc * 32 + 8 * fq;
        float rs8[8]; rstd8<1>(ss, row0, fq, rs8);
#pragma unroll
        for (int ai = 0; ai < 2; ++ai)
#pragma unroll
            for (int m = 0; m < 4; ++m) { const int row = row0 + ai * HALF + m * 16; const float rs = rs8[4 * ai + m]; float r[8];
#pragma unroll
                for (int n = 0; n < 2; ++n)
#pragma unroll
                    for (int i = 0; i < 4; ++i) { const float gv = acc[ai][0][m][n][i] * rs, uv = acc[ai][1][m][n][i] * rs;
                        r[4 * n + i] = gv * __builtin_amdgcn_rcpf(1.f + __builtin_amdgcn_exp2f(-gv * LOG2E)) * uv; }
                u32x4 w; w.x = pk_bf16(r[0], r[1]); w.y = pk_bf16(r[2], r[3]); w.z = pk_bf16(r[4], r[5]); w.w = pk_bf16(r[6], r[7]);
                *(u32x4*)(O + (size_t)row * DFF + col0) = w; }
    }
};
struct EpiPle {
    const bf16_t* Hin; bf16_t* Hout; const bf16_t* PPb; const float* ss; float* SSo;
    __device__ __forceinline__ void operator()(AccRef acc, const Unit& u, int wr, int wc, int fr, int fq) const {
        const int row0 = u.pm * BM + wr * 64 + fr;
        float rs8[8]; rstd8<1>(ss, row0, fq, rs8);
#pragma unroll
        for (int ai = 0; ai < 2; ++ai)
#pragma unroll
        for (int mp = 0; mp < 2; ++mp) {
            u32x4 pw[2][2], hv[2][2];
#pragma unroll
            for (int mm = 0; mm < 2; ++mm)
#pragma unroll
                for (int bj = 0; bj < 2; ++bj) { const size_t o_ = (size_t)(row0 + ai * HALF + (2 * mp + mm) * 16) * D + u.pn * BM + bj * HALF + wc * 32 + 8 * fq; pw[mm][bj] = *(const u32x4*)(PPb + o_); hv[mm][bj] = *(const u32x4*)(Hin + o_); }
            __builtin_amdgcn_sched_barrier(0);
#pragma unroll
            for (int mm = 0; mm < 2; ++mm) { const int m = 2 * mp + mm; const int row = row0 + ai * HALF + m * 16; const size_t ro = (size_t)row * D; const float rs = rs8[4 * ai + m]; float sq = 0.f;
#pragma unroll
                for (int bj = 0; bj < 2; ++bj) { const int col0 = u.pn * BM + bj * HALF + wc * 32 + 8 * fq;
                    const u32x4 p4 = pw[mm][bj], h4 = hv[mm][bj];
                    const f32x4 g0 = acc[ai][bj][m][0] * rs, g1 = acc[ai][bj][m][1] * rs;
                    float sg[8];
#pragma unroll
                    for (int i = 0; i < 4; ++i) { sg[i] = __builtin_amdgcn_rcpf(1.f + __builtin_amdgcn_exp2f(-g0[i] * LOG2E)); sg[4 + i] = __builtin_amdgcn_rcpf(1.f + __builtin_amdgcn_exp2f(-g1[i] * LOG2E)); }
                    u32x4 w; w.x = pk_bf16(bf_lo(h4.x) + sg[0] * bf_lo(p4.x), bf_hi(h4.x) + sg[1] * bf_hi(p4.x)); w.y = pk_bf16(bf_lo(h4.y) + sg[2] * bf_lo(p4.y), bf_hi(h4.y) + sg[3] * bf_hi(p4.y));
                    w.z = pk_bf16(bf_lo(h4.z) + sg[4] * bf_lo(p4.z), bf_hi(h4.z) + sg[5] * bf_hi(p4.z)); w.w = pk_bf16(bf_lo(h4.w) + sg[6] * bf_lo(p4.w), bf_hi(h4.w) + sg[7] * bf_hi(p4.w));
                    *(u32x4*)(Hout + ro + col0) = w; sq += sq8(w); }
                sq += __shfl_xor(sq, 16); sq += __shfl_xor(sq, 32);
                if (fq == 0) SSo[(size_t)row * 16 + u.pn * 4 + wc] = sq; } }
    }
};
}

#define XB_TMO      128
#define XB_XCNT(j)  (256  + 64 * (j))
#define XB_XSUB(j)  (1280 + 64 * (j))
#define XB_XGEN(j)  (2304 + 64 * (j))
#define XB_TOP      3328
#define XB_TOPGEN   3392
#define XCD_BAR_WORDS 3456
#define XB_SPIN_CAP (1u << 23)
__device__ __forceinline__ unsigned xb_ld(unsigned* p)              { return __hip_atomic_load(p, __ATOMIC_RELAXED, __HIP_MEMORY_SCOPE_AGENT); }
__device__ __forceinline__ unsigned xb_add(unsigned* p, unsigned v) { return __hip_atomic_fetch_add(p, v, __ATOMIC_RELAXED, __HIP_MEMORY_SCOPE_AGENT); }
__device__ __forceinline__ unsigned xb_xcc_id() { return (unsigned)__builtin_amdgcn_s_getreg((3 << 11) | 20) & 0xFu; }
#define XB_SPIN(cond, bar) do { unsigned _sp = 0; while (cond) { __builtin_amdgcn_s_sleep(1); \
    if ((++_sp & 255u) == 0u) { if (xb_ld(&(bar)[XB_TMO])) break; if (_sp > XB_SPIN_CAP) { atomicAdd(&(bar)[XB_TMO], 1u); break; } } } } while (0)
struct XcdBarrier { unsigned* bar; unsigned x; volatile LAS unsigned* st; };
__device__ __forceinline__ XcdBarrier xcd_barrier_post(unsigned* bar, volatile LAS unsigned* st) {
    XcdBarrier b; b.bar = bar; b.x = xb_xcc_id(); b.st = st;
    if (threadIdx.x == 0) (void)xb_add(&bar[XB_XCNT(b.x)], 1u);
    return b;
}
__device__ __forceinline__ void xcd_barrier_complete(unsigned* bar, unsigned x, unsigned& nloc, unsigned& nx) {
    const unsigned G = gridDim.x * gridDim.y * gridDim.z;
    unsigned sum, cnt, mine, sp = 0u;
    for (;;) {
        sum = 0u; cnt = 0u; mine = 0u;
#pragma unroll
        for (unsigned j = 0; j < 16; ++j) { const unsigned c = xb_ld(&bar[XB_XCNT(j)]); sum += c; cnt += (c > 0u) ? 1u : 0u; mine = (j == x) ? c : mine; }
        if (sum == G) break;
        __builtin_amdgcn_s_sleep(1);
        if ((++sp & 255u) == 0u) { if (xb_ld(&bar[XB_TMO])) break; if (sp > XB_SPIN_CAP) { atomicAdd(&bar[XB_TMO], 1u); break; } }
    }
    nloc = mine > 0u ? mine : 1u; nx = cnt > 0u ? cnt : 1u;
}
__device__ __forceinline__ void xcd_barrier(const XcdBarrier& b) {
    asm volatile("s_waitcnt vmcnt(0)" ::: "memory");
    __syncthreads();
    if (threadIdx.x == 0) {
        unsigned* bar = b.bar; unsigned bx_ = b.x;
        asm volatile("" : "+s"(bar), "+s"(bx_));
        __builtin_amdgcn_s_waitcnt(0);
        unsigned nloc = b.st[0], nx = b.st[1];
        if (nloc == 0u) { xcd_barrier_complete(bar, bx_, nloc, nx); b.st[0] = nloc; b.st[1] = nx; }
        const unsigned old = xb_add(&bar[XB_XSUB(bx_)], 1u);
        const unsigned gen = old / nloc;
        if (old + 1u == (gen + 1u) * nloc) {
            __builtin_amdgcn_fence(__ATOMIC_RELEASE, "agent");
            asm volatile("s_waitcnt vmcnt(0)" ::: "memory");
            const unsigned og = xb_add(&bar[XB_TOP], 1u);
            const unsigned tg = og / nx;
            if (og + 1u == (tg + 1u) * nx) xb_add(&bar[XB_TOPGEN], 1u);
            else XB_SPIN(xb_ld(&bar[XB_TOPGEN]) == tg, bar);
            __builtin_amdgcn_fence(__ATOMIC_ACQUIRE, "agent");
            xb_add(&bar[XB_XGEN(bx_)], 1u);
            asm volatile("s_waitcnt vmcnt(0)" ::: "memory");
        } else {
            XB_SPIN(xb_ld(&bar[XB_XGEN(bx_)]) == gen, bar);
            __builtin_amdgcn_fence(__ATOMIC_ACQUIRE, "agent");
            asm volatile("s_waitcnt vmcnt(0)" ::: "memory");
        }
    }
    __syncthreads();
}

struct MapIn { const float* W;
    __device__ __forceinline__ void operator()(int n, const float*& src, int& ld, float& sc) const {
        ld = DIN; sc = 1.f; int o = -1;
        if (n < 640) o = n;
        else if (n < 672) { const int w = n - 640; o = 640 + (w >> 1) + 16 * (w & 1); }
        else if (n < 680) { o = 1696 + (n - 672); sc = 0.044194173824159216f; }
        else if (n < 704) o = -1;
        else if (n < 1024) { o = 672 + (n - 704); sc = LOG2E * 0.125f; }
        else if (n < 1088) o = 992 + (n - 1024);
        else if (n < 1152) o = 1056 + (n - 1088);
        else if (n < 1664) o = 1120 + (n - 1152);
        else if (n < 1728) o = 1632 + (n - 1664);
        else if (n < 2048) { o = 1704 + (n - 1728); sc = LOG2E * 0.125f; }
        else if (n < 2368) o = 2024 + (n - 2048);
        else if (n < 2688) o = 2344 + (n - 2368);
        src = o >= 0 ? W + o : nullptr; } };
struct MapUq { const float* W;
    __device__ __forceinline__ void operator()(int n, const float*& src, int& ld, float& sc) const {
        ld = 576; sc = 0.10206207261596575f * LOG2E;
        if (n >= 576) { src = nullptr; return; }
        const int hh = n / 96, w = n % 96; const int o = hh * 96 + (w < 64 ? w : 64 + ((w - 64) >> 1) + 16 * ((w - 64) & 1)); src = W + o; } };
struct MapUkv { const float* W;
    __device__ __forceinline__ void operator()(int n, const float*& src, int& ld, float& sc) const {
        ld = 768; sc = 1.f; int o; if (n < 384) { o = (n >> 6) * 128 + (n & 63); } else { const int n2 = n - 384; o = (n2 >> 6) * 128 + 64 + (n2 & 63); } src = W + o; } };
struct MapId { const float* W; int ldw;
    __device__ __forceinline__ void operator()(int n, const float*& src, int& ld, float& sc) const { ld = ldw; sc = 1.f; src = W + n; } };
struct MapGu { const float* Wg; const float* Wu;
    __device__ __forceinline__ void operator()(int n, const float*& src, int& ld, float& sc) const {
        ld = DFF; sc = 1.f; const int tile = n >> 8, x = n & 255; src = (x < 128) ? Wg + tile * 128 + x : Wu + tile * 128 + (x - 128); } };

template <class Map>
__device__ __forceinline__ void conv_item(const Map& mp, int K, bf16_t* WT, LAS float* scr, int item, int nblk, const float* gain = nullptr) {
    const int lane = opaque_tid() & 63;
    const int kb = item / nblk, nb = item % nblk, k0 = 64 * kb, n0 = 32 * nb;
    const float* src; int ld; float sc; mp(n0 + (lane & 31), src, ld, sc);
    const float gl = gain ? gain[k0 + lane] : 1.f;
    float v[32];
#pragma unroll
    for (int i = 0; i < 32; ++i) v[i] = 0.f;
    if (src) { const float* sp = src + (size_t)(k0 + (lane >> 5)) * ld;
#pragma unroll
        for (int i = 0; i < 32; ++i) v[i] = sp[(size_t)(2 * i) * ld]; }
#pragma unroll
    for (int i = 0; i < 32; ++i) { const int kk = 2 * i + (lane >> 5); scr[kk * 33 + (lane & 31)] = v[i] * sc * __shfl(gl, kk); }
    asm volatile("s_waitcnt lgkmcnt(0)" ::: "memory");
    const int c = lane & 7;
#pragma unroll
    for (int j = 0; j < 4; ++j) { const int n = (lane >> 3) + 8 * j; const LAS float* s = scr + (8 * c) * 33 + n;
        u32x4 o; o.x = pk_bf16(s[0 * 33], s[1 * 33]); o.y = pk_bf16(s[2 * 33], s[3 * 33]); o.z = pk_bf16(s[4 * 33], s[5 * 33]); o.w = pk_bf16(s[6 * 33], s[7 * 33]);
        *(u32x4*)(WT + (size_t)(n0 + n) * K + k0 + 8 * c) = o; }
    asm volatile("s_waitcnt lgkmcnt(0)" ::: "memory");
}

__device__ __forceinline__ void x_to_h_rows(const float* X, bf16_t* H, float* SSo, int gw, int ngw) {
    const int lane = opaque_tid() & 63;
    for (int m0 = gw; m0 < M; m0 += 4 * ngw) {
        f32x4 v[4][4];
#pragma unroll
        for (int r = 0; r < 4; ++r) { const int m = min(m0 + r * ngw, M - 1);
#pragma unroll
            for (int j = 0; j < 4; ++j) v[r][j] = ((const f32x4*)(X + (size_t)m * D) + lane)[64 * j]; }
        __builtin_amdgcn_sched_barrier(0);
#pragma unroll
        for (int r = 0; r < 4; ++r) { const int m = m0 + r * ngw; if (m < M) {
            u32x2* o8 = (u32x2*)(H + (size_t)m * D) + lane; float sq = 0.f;
#pragma unroll
            for (int j = 0; j < 4; ++j) { u32x2 w; w.x = pk_bf16(v[r][j][0], v[r][j][1]); w.y = pk_bf16(v[r][j][2], v[r][j][3]); o8[64 * j] = w;
                sq += (bf_lo(w.x) * bf_lo(w.x) + bf_hi(w.x) * bf_hi(w.x)) + (bf_lo(w.y) * bf_lo(w.y) + bf_hi(w.y) * bf_hi(w.y)); }
            sq = wave_sum(sq);
            if (lane < 16) SSo[(size_t)m * 16 + lane] = (lane == 0) ? sq : 0.f; } }
    }
}
__device__ __forceinline__ void final_norm_rows(const bf16_t* H, const float* gain, float* Out, int gw, int ngw) {
    const int lane = opaque_tid() & 63;
    f32x4 g[4];
#pragma unroll
    for (int j = 0; j < 4; ++j) g[j] = *(const f32x4*)(gain + 256 * j + 4 * lane);
    for (int m0 = gw; m0 < M; m0 += 4 * ngw) {
        u32x2 hw[4][4];
#pragma unroll
        for (int r = 0; r < 4; ++r) { const int m = min(m0 + r * ngw, M - 1);
#pragma unroll
            for (int j = 0; j < 4; ++j) hw[r][j] = ((const u32x2*)(H + (size_t)m * D) + lane)[64 * j]; }
        __builtin_amdgcn_sched_barrier(0);
#pragma unroll
        for (int r = 0; r < 4; ++r) { const int m = m0 + r * ngw; if (m < M) {
            f32x4 v[4]; float sq = 0.f;
#pragma unroll
            for (int j = 0; j < 4; ++j) { const u32x2 w = hw[r][j]; v[j] = (f32x4){bf_lo(w.x), bf_hi(w.x), bf_lo(w.y), bf_hi(w.y)}; sq += (v[j][0] * v[j][0] + v[j][1] * v[j][1]) + (v[j][2] * v[j][2] + v[j][3] * v[j][3]); }
            const float rr = rsqrtf(wave_sum(sq) * (1.f / D) + EPS);
            f32x4* orow = (f32x4*)(Out + (size_t)m * D) + lane;
#pragma unroll
            for (int j = 0; j < 4; ++j) orow[64 * j] = v[j] * rr * g[j]; } }
    }
}
__device__ __forceinline__ void cvt_p_rows(const float* Pin, bf16_t* PB, int gbase, int nthreads) {
    const int gtid = gbase + opaque_tid();
    const size_t n8 = (size_t)M * PLE / 8;
    for (size_t i0 = gtid; i0 < n8; i0 += (size_t)4 * nthreads) {
        f32x4 a[4], b[4];
#pragma unroll
        for (int r = 0; r < 4; ++r) { const size_t i = (i0 + (size_t)r * nthreads < n8) ? i0 + (size_t)r * nthreads : i0; a[r] = *(const f32x4*)(Pin + i * 8); b[r] = *(const f32x4*)(Pin + i * 8 + 4); }
        __builtin_amdgcn_sched_barrier(0);
#pragma unroll
        for (int r = 0; r < 4; ++r) { const size_t i = i0 + (size_t)r * nthreads; if (i < n8) {
            u32x4 w; w.x = pk_bf16(a[r][0], a[r][1]); w.y = pk_bf16(a[r][2], a[r][3]); w.z = pk_bf16(b[r][0], b[r][1]); w.w = pk_bf16(b[r][2], b[r][3]); *(u32x4*)(PB + i * 8) = w; } }
    }
}
constexpr int MLA_KS = 208, MLA_VS = 144, MLA_KB = 64 * MLA_KS, MLA_VB = 64 * MLA_VS;
#define MLA_BAR() asm volatile("s_waitcnt lgkmcnt(0)\n\ts_barrier" ::: "memory")
#define MLA_KREADS_R(a, b) _Pragma("unroll") for (int ks = (a); ks < (b); ++ks) { kfr[ks][0] = *(LAS const bf16x8*)(kl + ks * 32); kfr[ks][1] = *(LAS const bf16x8*)(kl + 32 * MLA_KS + ks * 32); }
#define MLA_VREADS_R(a, b) _Pragma("unroll") for (int kk = (a); kk < (b); ++kk) { vt[kk][0] = ldtr(vl + (16 * kk) * MLA_VS); vt[kk][1] = ldtr(vl + (16 * kk + 8) * MLA_VS); vt[kk][2] = ldtr(vl + (16 * kk) * MLA_VS + 64); vt[kk][3] = ldtr(vl + (16 * kk + 8) * MLA_VS + 64); }
#define MLA_PV() do { _Pragma("unroll") for (int kk = 0; kk < 4; ++kk) { o0 = mfma32(cat8(vt[kk][0], vt[kk][1]), pb[kk], o0); o1 = mfma32(cat8(vt[kk][2], vt[kk][3]), pb[kk], o1); } } while (0)
__device__ __forceinline__ void mla_qk(LAS const unsigned char* kl, const bf16x8 (&qf)[6], const f32x16& negm, f32x16& s0, f32x16& s1) {
    bf16x8 kfr[6][2];
    MLA_KREADS_R(0, 6);
    __builtin_amdgcn_sched_barrier(0);
    s0 = mfma32(kfr[0][0], qf[0], negm); s1 = mfma32(kfr[0][1], qf[0], negm);
#pragma unroll
    for (int ks = 1; ks < 6; ++ks) { s0 = mfma32(kfr[ks][0], qf[ks], s0); s1 = mfma32(kfr[ks][1], qf[ks], s1); }
}
__device__ __forceinline__ void mla_pv(LAS const unsigned char* vl, const bf16x8 (&pb)[4], f32x16& o0, f32x16& o1) {
    s16x4 vt[4][4];
    MLA_VREADS_R(0, 4);
    __builtin_amdgcn_sched_barrier(0);
    MLA_PV();
}
__device__ __forceinline__ void mla_mfull(LAS const unsigned char* kl, LAS const unsigned char* vl, const bf16x8 (&qf)[6], const f32x16& negm, f32x16& s0, f32x16& s1, const bf16x8 (&pb)[4], f32x16& o0, f32x16& o1) {
    bf16x8 kfr[6][2]; s16x4 vt[4][4];
    MLA_KREADS_R(0, 4); MLA_VREADS_R(0, 1);
    __builtin_amdgcn_sched_barrier(0);
    __builtin_amdgcn_s_setprio(1);
    s0 = mfma32(kfr[0][0], qf[0], negm); s1 = mfma32(kfr[0][1], qf[0], negm); s0 = mfma32(kfr[1][0], qf[1], s0); s1 = mfma32(kfr[1][1], qf[1], s1);
    __builtin_amdgcn_sched_barrier(0);
    MLA_KREADS_R(4, 6);
    __builtin_amdgcn_sched_barrier(0);
    s0 = mfma32(kfr[2][0], qf[2], s0); s1 = mfma32(kfr[2][1], qf[2], s1); s0 = mfma32(kfr[3][0], qf[3], s0); s1 = mfma32(kfr[3][1], qf[3], s1);
    __builtin_amdgcn_sched_barrier(0);
    MLA_VREADS_R(1, 4);
    __builtin_amdgcn_sched_barrier(0);
    s0 = mfma32(kfr[4][0], qf[4], s0); s1 = mfma32(kfr[4][1], qf[4], s1); s0 = mfma32(kfr[5][0], qf[5], s0); s1 = mfma32(kfr[5][1], qf[5], s1);
    __builtin_amdgcn_sched_barrier(0);
    MLA_PV();
    __builtin_amdgcn_s_setprio(0);
}
__device__ __forceinline__ void mla_vseg(f32x16& s0, f32x16& s1, f32x16& o0, f32x16& o1, f32x16& negm, bf16x8 (&pb)[4], float& mref, float& lsum, int j, int ntw, int tq, int hi) {
    if (j >= ntw - 1) {
#pragma unroll
        for (int r = 0; r < 16; ++r) { const int key = j * 64 + crow(r, hi); if (key > tq) s0[r] = -1e30f; if (key + 32 > tq) s1[r] = -1e30f; }
    }
    float mx = fmaxf(s0[0], s1[0]);
#pragma unroll
    for (int r = 1; r < 16; ++r) mx = fmaxf(fmaxf(mx, s0[r]), s1[r]);
    { const auto rr = __builtin_amdgcn_permlane32_swap(__float_as_uint(mx), __float_as_uint(mx), false, false); mx = fmaxf(__uint_as_float(rr[0]), __uint_as_float(rr[1])); }
    if (j == 0 || __any(mx > 8.f)) {
        const float dl = (j == 0) ? mx : fmaxf(mx, 0.f), alpha = __builtin_amdgcn_exp2f(-dl);
        mref += dl; lsum *= alpha; const float nm = -mref;
#pragma unroll
        for (int r = 0; r < 16; ++r) { float a = s0[r], c = s1[r], e = o0[r], f = o1[r], g = negm[r];
            asm volatile("v_sub_f32 %0, %0, %5\n\tv_sub_f32 %1, %1, %5\n\tv_mul_f32 %2, %2, %6\n\tv_mul_f32 %3, %3, %6\n\tv_mov_b32 %4, %7" : "+v"(a), "+v"(c), "+v"(e), "+v"(f), "+v"(g) : "v"(dl), "v"(alpha), "v"(nm));
            s0[r] = a; s1[r] = c; o0[r] = e; o1[r] = f; negm[r] = g; }
    }
    float psA = 0.f, psB = 0.f;
#pragma unroll
    for (int r = 0; r < 16; ++r) { float a = __builtin_amdgcn_exp2f(s0[r]), c = __builtin_amdgcn_exp2f(s1[r]); asm volatile("" : "+v"(a), "+v"(c)); s0[r] = a; s1[r] = c;
        psA += a; psB += c; asm volatile("" : "+v"(psA), "+v"(psB)); }
    lsum += psA + psB;
    pb[0] = pack8(s0[0], s0[1], s0[2], s0[3], s0[4], s0[5], s0[6], s0[7]); pb[1] = pack8(s0[8], s0[9], s0[10], s0[11], s0[12], s0[13], s0[14], s0[15]);
    pb[2] = pack8(s1[0], s1[1], s1[2], s1[3], s1[4], s1[5], s1[6], s1[7]); pb[3] = pack8(s1[8], s1[9], s1[10], s1[11], s1[12], s1[13], s1[14], s1[15]);
}
__device__ __forceinline__ void mla_unit(LAS unsigned char* L, const bf16_t* QM, const bf16_t* KV, const bf16_t* KR, bf16_t* MIX, int b, int h, int qt) {
    const int tid = opaque_tid(), lane = tid & 63, wid = __builtin_amdgcn_readfirstlane(tid >> 6), r32 = lane & 31, hi = lane >> 5, grp = wid >> 2;
    const size_t rowbase = (size_t)b * SEQ; const int q0 = qt * 256, qw = q0 + wid * 32, tq = qw + r32;
    bf16x8 qf[6];
    { const bf16_t* qp = QM + (rowbase + tq) * QM_LD + h * 96 + hi * 8;
#pragma unroll
      for (int ks = 0; ks < 6; ++ks) qf[ks] = *(const bf16x8*)(qp + 16 * ks); }
    const int NT = (q0 + 256) / 64, ntw = (qw >> 6) + 1;
    const int krow = tid >> 3, kch = tid & 7, rrow = tid >> 2, rch = tid & 3;
    const unsigned char* bK = (const unsigned char*)(KV + rowbase * KV_LD + h * 64);
    const unsigned char* bR = (const unsigned char*)(KR + rowbase * 32);
    const unsigned oK = (unsigned)(krow * KV_LD + kch * 8) * 2u, oR = (unsigned)((rrow & 63) * 32 + rch * 8) * 2u;
    const int lK = krow * MLA_KS + kch * 16, lR = (rrow & 63) * MLA_KS + 128 + rch * 16, lV = 2 * MLA_KB + krow * MLA_VS + kch * 16;
    u32x4 sk, sv, sr;
#define MLA_LOADK(t) do { const size_t go_ = (size_t)(t) * 64; sk = *(const u32x4*)(bK + go_ * (KV_LD * 2) + oK); if (tid < 256) sr = *(const u32x4*)(bR + go_ * 64 + oR); } while (0)
#define MLA_LOADV(t) do { sv = *(const u32x4*)(bK + (size_t)(t) * 64 * (KV_LD * 2) + 768 + oK); } while (0)
#define MLA_WRITEK(t) do { const int ko_ = ((t) & 1) * MLA_KB; *(LAS u32x4*)(L + ko_ + lK) = sk; if (tid < 256) *(LAS u32x4*)(L + ko_ + lR) = sr; } while (0)
#define MLA_WRITEV(t) do { *(LAS u32x4*)(L + ((t) & 1) * MLA_VB + lV) = sv; } while (0)
    sr = (u32x4){0, 0, 0, 0};
    MLA_LOADK(0); MLA_WRITEK(0);
    MLA_BAR();
    f32x16 o0 = {}, o1 = {}, negm = {}, s0 = {}, s1 = {}; float mref = 0.f, lsum = 0.f;
    bf16x8 pb[4] = {};
    const int i16 = lane & 15, g4 = lane >> 4;
    LAS const unsigned char* klb = L + r32 * MLA_KS + hi * 16;
    LAS const unsigned char* vlb = L + 2 * MLA_KB + (4 * hi + (i16 >> 2)) * MLA_VS + (16 * (g4 & 1) + 4 * (i16 & 3)) * 2;
    if (grp != 0) __builtin_amdgcn_s_setprio(1);
    if (grp == 0) {
        MLA_LOADK(1); MLA_LOADV(0);
        mla_qk(klb, qf, negm, s0, s1);
        MLA_BAR();
        for (int j = 0; j < NT - 1; ++j) {
            mla_vseg(s0, s1, o0, o1, negm, pb, mref, lsum, j, ntw, tq, hi);
            MLA_WRITEK(j + 1); MLA_WRITEV(j);
            MLA_BAR();
            MLA_LOADK(min(j + 2, NT - 1)); MLA_LOADV(j + 1);
            mla_mfull(klb + ((j + 1) & 1) * MLA_KB, vlb + (j & 1) * MLA_VB, qf, negm, s0, s1, pb, o0, o1);
            MLA_BAR();
        }
        mla_vseg(s0, s1, o0, o1, negm, pb, mref, lsum, NT - 1, ntw, tq, hi);
        MLA_WRITEV(NT - 1);
        MLA_BAR();
        mla_pv(vlb + ((NT - 1) & 1) * MLA_VB, pb, o0, o1);
        MLA_BAR();
        MLA_BAR();
    } else {
        MLA_LOADK(1); MLA_LOADV(0);
        MLA_BAR();
        mla_qk(klb, qf, negm, s0, s1);
        MLA_WRITEK(1); MLA_WRITEV(0);
        MLA_BAR();
        for (int j = 0; j < NT - 1; ++j) {
            MLA_LOADK(min(j + 2, NT - 1)); MLA_LOADV(j + 1);
            mla_vseg(s0, s1, o0, o1, negm, pb, mref, lsum, j, ntw, tq, hi);
            MLA_BAR();
            mla_mfull(klb + ((j + 1) & 1) * MLA_KB, vlb + (j & 1) * MLA_VB, qf, negm, s0, s1, pb, o0, o1);
            MLA_WRITEK(j + 2); MLA_WRITEV(j + 1);
            MLA_BAR();
        }
        mla_vseg(s0, s1, o0, o1, negm, pb, mref, lsum, NT - 1, ntw, tq, hi);
        MLA_BAR();
        mla_pv(vlb + ((NT - 1) & 1) * MLA_VB, pb, o0, o1);
        MLA_BAR();
    }
    __builtin_amdgcn_s_setprio(0);
    lsum += __shfl_xor(lsum, 32);
    const float inv = 1.f / lsum;
    const int tid2 = opaque_tid();
    bf16_t* orow = MIX + (rowbase + q0 + (tid2 >> 6) * 32 + (tid2 & 31)) * D + h * 64 + 4 * ((tid2 >> 5) & 1);
#pragma unroll
    for (int g = 0; g < 4; ++g) {
        u32x2 w0, w1; w0.x = pk_bf16(o0[4 * g] * inv, o0[4 * g + 1] * inv); w0.y = pk_bf16(o0[4 * g + 2] * inv, o0[4 * g + 3] * inv);
        w1.x = pk_bf16(o1[4 * g] * inv, o1[4 * g + 1] * inv); w1.y = pk_bf16(o1[4 * g + 2] * inv, o1[4 * g + 3] * inv);
        *(u32x2*)(orow + 8 * g) = w0; *(u32x2*)(orow + 32 + 8 * g) = w1;
    }
}

constexpr int SB_VS = 144;
__device__ __forceinline__ void sb_unit(LAS unsigned char* L, const bf16_t* P, bf16_t* MIX, int b, int qt, int h) {
    const int tid = opaque_tid(), lane = tid & 63, wid = __builtin_amdgcn_readfirstlane(tid >> 6), r32 = lane & 31, hi = lane >> 5;
    const size_t rowbase = (size_t)b * SEQ; const int qw = qt * 256 + wid * 32, tq = qw + r32;
    LAS unsigned char* vl = L + wid * (32 * SB_VS);
    bf16x8 qf[4];
    { const bf16_t* qp = P + (rowbase + tq) * NP + C_SQ + h * 64 + hi * 8;
#pragma unroll
      for (int ks = 0; ks < 4; ++ks) qf[ks] = *(const bf16x8*)(qp + 16 * ks); }
    f32x16 o0 = {}, o1 = {}; float R = 0.f;
    const int i16 = lane & 15, g4 = lane >> 4;
    const int vtr_off = (4 * hi + (i16 >> 2)) * SB_VS + (16 * (g4 & 1) + 4 * (i16 & 3)) * 2;
    for (int kb = qw >> 5; kb >= 0; --kb) {
        const int k0 = kb * 32;
        const bf16_t* kp = P + (rowbase + k0 + r32) * NP + C_SK + h * 64 + hi * 8;
        bf16x8 kf[4];
#pragma unroll
        for (int ks = 0; ks < 4; ++ks) kf[ks] = *(const bf16x8*)(kp + 16 * ks);
        { u32x4 vst[4];
#pragma unroll
          for (int i = 0; i < 4; ++i) vst[i] = *(const u32x4*)(P + (rowbase + k0 + 8 * i + (lane >> 3)) * NP + C_SV + h * 64 + (lane & 7) * 8);
          __builtin_amdgcn_sched_barrier(0);
#pragma unroll
          for (int i = 0; i < 4; ++i) *(LAS u32x4*)(vl + (8 * i + (lane >> 3)) * SB_VS + (lane & 7) * 16) = vst[i]; }
        f32x16 z = {};
#pragma unroll
        for (int ks = 0; ks < 4; ++ks) z = mfma32(kf[ks], qf[ks], z);
        float lb[16], l1[16];
        const bool diag = (k0 == qw);
#pragma unroll
        for (int r = 0; r < 16; ++r) { const float zz = z[r]; const float e = __builtin_amdgcn_exp2f(-fabsf(zz)); const float Lg = __builtin_amdgcn_logf(1.f + e);
            lb[r] = fminf(zz, 0.f) - Lg; l1[r] = lb[r] - zz;
            if (diag && crow(r, hi) >= r32) { lb[r] = -1e30f; l1[r] = 0.f; } }
        float G[4], PG[4], T[4];
#pragma unroll
        for (int g = 0; g < 4; ++g) { G[g] = (l1[4 * g] + l1[4 * g + 1]) + (l1[4 * g + 2] + l1[4 * g + 3]); PG[g] = __shfl_xor(G[g], 32); T[g] = G[g] + PG[g]; }
        float tail[4]; tail[3] = 0.f; tail[2] = T[3]; tail[1] = T[3] + T[2]; tail[0] = tail[1] + T[1];
        float w[16];
#pragma unroll
        for (int g = 0; g < 4; ++g) { float s = R + tail[g] + (hi == 0 ? PG[g] : 0.f);
            w[4 * g + 3] = __builtin_amdgcn_exp2f(lb[4 * g + 3] + s); s += l1[4 * g + 3];
            w[4 * g + 2] = __builtin_amdgcn_exp2f(lb[4 * g + 2] + s); s += l1[4 * g + 2];
            w[4 * g + 1] = __builtin_amdgcn_exp2f(lb[4 * g + 1] + s); s += l1[4 * g + 1];
            w[4 * g + 0] = __builtin_amdgcn_exp2f(lb[4 * g + 0] + s); }
        R += tail[0] + T[0];
        const bf16x8 pb0 = pack8(w[0], w[1], w[2], w[3], w[4], w[5], w[6], w[7]), pb1 = pack8(w[8], w[9], w[10], w[11], w[12], w[13], w[14], w[15]);
        asm volatile("s_waitcnt lgkmcnt(0)" ::: "memory");
        LAS const unsigned char* vp = vl + vtr_off;
        { const bf16x8 va = cat8(ldtr(vp), ldtr(vp + 8 * SB_VS)), vb = cat8(ldtr(vp + 64), ldtr(vp + 8 * SB_VS + 64)); o0 = mfma32(va, pb0, o0); o1 = mfma32(vb, pb0, o1); }
        { const bf16x8 va = cat8(ldtr(vp + 16 * SB_VS), ldtr(vp + 24 * SB_VS)), vb = cat8(ldtr(vp + 16 * SB_VS + 64), ldtr(vp + 24 * SB_VS + 64)); o0 = mfma32(va, pb1, o0); o1 = mfma32(vb, pb1, o1); }
        asm volatile("s_waitcnt lgkmcnt(0)" ::: "memory");
        if (__all(R < -160.f)) break;
    }
    bf16_t* orow = MIX + (rowbase + tq) * D + 704 + h * 64 + 4 * hi;
#pragma unroll
    for (int g = 0; g < 4; ++g) {
        u32x2 w0, w1; w0.x = pk_bf16(o0[4 * g], o0[4 * g + 1]); w0.y = pk_bf16(o0[4 * g + 2], o0[4 * g + 3]);
        w1.x = pk_bf16(o1[4 * g], o1[4 * g + 1]); w1.y = pk_bf16(o1[4 * g + 2], o1[4 * g + 3]);
        *(u32x2*)(orow + 8 * g) = w0; *(u32x2*)(orow + 32 + 8 * g) = w1;
    }
}

constexpr int DSA_CAP = 256;
constexpr int DSL_CAP = 512, DSL_KS = 100;
struct DsaPrm { LAS int* b0; LAS int* b1; LAS int* krem; LAS int* cin; LAS unsigned* nsel; LAS unsigned* ncand; LAS float* sc0; LAS float* off0; LAS float* sc1; LAS float* off1; LAS int* part; LAS int* flag; };
__device__ __forceinline__ DsaPrm dsa_prm(LAS unsigned char* L) {
    DsaPrm p; LAS int* w = (LAS int*)(L + L_PRM);
    p.b0 = w; p.b1 = w + 32; p.krem = w + 64; p.cin = w + 96; p.nsel = (LAS unsigned*)(w + 128); p.ncand = (LAS unsigned*)(w + 160);
    p.sc0 = (LAS float*)(w + 192); p.off0 = (LAS float*)(w + 224); p.sc1 = (LAS float*)(w + 256); p.off1 = (LAS float*)(w + 288); p.part = w + 320; p.flag = w + 832; return p;
}
struct DsaLane { float sc0, off0, sc1, off1; int b0, b1; };
template <int MODE, bool DIAG>
__device__ __forceinline__ void dsa_classify(LAS unsigned char* L, const float (&x)[16], const DsaLane& dl, int kb, int tq, int qloc, int wid, int lane) {
    const int g4 = lane >> 4;
    int key0 = kb + 4 * g4;
    if (DIAG) asm volatile("" : "+v"(key0));
    LAS unsigned* hist = (LAS unsigned*)(L + L_H) + qloc * 1024;
    if (MODE == 3) {
        const float b0f = (dl.b0 == 0) ? -3.0e38f : (float)dl.b0;
        unsigned mge = 0u;
#pragma unroll
        for (int i = 0; i < 16; ++i) {
            const bool valid = !DIAG || (key0 + 16 * (i >> 2) + (i & 3) <= tq);
            unsigned gb = (valid && __builtin_fmaf(x[i], dl.sc0, dl.off0) >= b0f) ? 1u : 0u; asm volatile("" : "+v"(gb));
            mge |= gb << i;
        }
        if (mge) {
            LAS float* xs = (LAS float*)(L + L_H + 98304 + wid * 4096);
#pragma unroll
            for (int i = 0; i < 16; ++i) xs[i * 64 + lane] = x[i];
            const DsaPrm pr = dsa_prm(L);
            LAS float* ls = (LAS float*)(L + L_H) + qloc * DSL_CAP; LAS unsigned short* lk = (LAS unsigned short*)(L + L_H + 65536) + qloc * DSL_CAP;
#pragma unroll 1
            while (mge) { const int i = __builtin_ctz(mge); mge &= mge - 1u;
                const float xv = xs[i * 64 + lane];
                const unsigned slot = __hip_atomic_fetch_add(pr.ncand + qloc, 1u, __ATOMIC_RELAXED, __HIP_MEMORY_SCOPE_WORKGROUP);
                if (slot < (unsigned)DSL_CAP) { ls[slot] = xv; lk[slot] = (unsigned short)(kb + 16 * (i >> 2) + 4 * g4 + (i & 3)); } }
        }
    } else if (MODE != 2) {
#pragma unroll
        for (int i = 0; i < 16; ++i) {
            const float xv = x[i];
            const bool valid = !DIAG || (key0 + 16 * (i >> 2) + (i & 3) <= tq);
            int bin = (int)__builtin_fmaf(xv, dl.sc0, dl.off0); bin = min(max(bin, 0), 1023);
            if (MODE == 0) { if (valid) __hip_atomic_fetch_add(hist + bin, 1u, __ATOMIC_RELAXED, __HIP_MEMORY_SCOPE_WORKGROUP); }
            else { int c1 = (int)__builtin_fmaf(xv, dl.sc1, dl.off1); c1 = min(max(c1, 0), 1023);
                if (valid && bin == dl.b0) __hip_atomic_fetch_add(hist + c1, 1u, __ATOMIC_RELAXED, __HIP_MEMORY_SCOPE_WORKGROUP); }
        }
    } else {
        const float b0f = (dl.b0 == 0) ? -3.0e38f : (float)dl.b0;
        unsigned mge = 0u;
#pragma unroll
        for (int i = 0; i < 16; ++i) {
            const bool valid = !DIAG || (key0 + 16 * (i >> 2) + (i & 3) <= tq);
            unsigned gb = (valid && __builtin_fmaf(x[i], dl.sc0, dl.off0) >= b0f) ? 1u : 0u; asm volatile("" : "+v"(gb));
            mge |= gb << i;
        }
        if (mge) {
            LAS float* xs = (LAS float*)(L + L_H + 65536 + wid * 4096);
#pragma unroll
            for (int i = 0; i < 16; ++i) xs[i * 64 + lane] = x[i];
            const DsaPrm pr = dsa_prm(L);
            LAS float* cand_s = (LAS float*)(L + L_H) + qloc * DSA_CAP; LAS unsigned* cand_k = (LAS unsigned*)(L + L_H + 32768) + qloc * DSA_CAP;
            unsigned w0 = 0u, w1 = 0u;
#pragma unroll 1
            while (mge) { const int i = __builtin_ctz(mge); mge &= mge - 1u;
                const float xv = xs[i * 64 + lane];
                int bin = (int)__builtin_fmaf(xv, dl.sc0, dl.off0); bin = min(max(bin, 0), 1023);
                int c1 = (int)__builtin_fmaf(xv, dl.sc1, dl.off1); c1 = min(max(c1, 0), 1023);
                const int koff = 16 * (i >> 2) + 4 * g4 + (i & 3);
                if (bin > dl.b0 || (bin == dl.b0 && c1 > dl.b1)) { if (koff < 32) w0 |= 1u << koff; else w1 |= 1u << (koff - 32); }
                else if (bin == dl.b0 && c1 == dl.b1) { const unsigned cb = __hip_atomic_fetch_add(pr.ncand + qloc, 1u, __ATOMIC_RELAXED, __HIP_MEMORY_SCOPE_WORKGROUP);
                    if (cb < (unsigned)DSA_CAP) { cand_s[cb] = xv; cand_k[cb] = (unsigned)(kb + koff); } }
            }
            LAS unsigned* bm = (LAS unsigned*)(L + L_H + 98304) + qloc * 256 + (kb >> 5);
            if (w0) __hip_atomic_fetch_or(bm, w0, __ATOMIC_RELAXED, __HIP_MEMORY_SCOPE_WORKGROUP);
            if (w1) __hip_atomic_fetch_or(bm + 1, w1, __ATOMIC_RELAXED, __HIP_MEMORY_SCOPE_WORKGROUP);
        }
    }
}
#define DSA_MM(dst, st) do { constexpr int h0_ = ((st) & 1) ? 4 : 0, nh_ = ((st) & 1) ? 5 : 4; \
        _Pragma("unroll") for (int h_ = 0; h_ < nh_; ++h_) dst[h_] = mfma16(kf[(st) >> 1][0], qf[h0_ + h_][0], (f32x4){0.f, 0.f, 0.f, 0.f}); \
        _Pragma("unroll") for (int h_ = 0; h_ < nh_; ++h_) dst[h_] = mfma16(kf[(st) >> 1][1], qf[h0_ + h_][1], dst[h_]); } while (0)
__device__ __forceinline__ float add_asm(float y, float t) { asm volatile("v_add_f32 %0, %1, %0" : "+v"(t) : "v"(y)); return t; }
__device__ __forceinline__ float fma_abs(float y, float sgn, float t) { asm volatile("v_fma_f32 %0, |%1|, %2, %0" : "+v"(t) : "v"(y), "v"(sgn)); return t; }
#define DSA_VA(src, st) do { constexpr int h0_ = ((st) & 1) ? 4 : 0; f32x4 t_ = xa[(st) >> 1]; \
        _Pragma("unroll") for (int h_ = 0; h_ < 4; ++h_) { const float s_ = sg[h0_ + h_]; \
            _Pragma("unroll") for (int r_ = 0; r_ < 4; ++r_) t_[r_] = fma_abs(src[h_][r_], s_, t_[r_]); } \
        if ((st) & 1) { _Pragma("unroll") for (int r_ = 0; r_ < 4; ++r_) t_[r_] = add_asm(src[4][r_], t_[r_]); } \
        xa[(st) >> 1] = t_; } while (0)
#define DSA_SGB(n) do { _Pragma("unroll") for (int i_ = 0; i_ < (n); ++i_) { __builtin_amdgcn_sched_group_barrier(0x008, 1, 0); __builtin_amdgcn_sched_group_barrier(0x002, 2, 0); } } while (0)
template <int MODE>
__device__ __forceinline__ void dsa_group(LAS unsigned char* L, const bf16x8 (&kf)[4][2], const bf16x8 (&qf)[9][2], const float (&sg)[8], const DsaLane& dl, int kb, int t0, int tq, int qloc, int wid, int lane) {
    f32x4 xa[4];
#pragma unroll
    for (int b_ = 0; b_ < 4; ++b_) xa[b_] = (f32x4){0.f, 0.f, 0.f, 0.f};
    f32x4 aA[5], aB[5];
#define DSA_SB() __builtin_amdgcn_sched_barrier(0)
    DSA_MM(aA, 0); DSA_SB();
    DSA_MM(aB, 1); DSA_SB(); DSA_VA(aA, 0); DSA_SB();
    DSA_MM(aA, 2); DSA_SB(); DSA_VA(aB, 1); DSA_SB();
    DSA_MM(aB, 3); DSA_SB(); DSA_VA(aA, 2); DSA_SB();
    DSA_MM(aA, 4); DSA_SB(); DSA_VA(aB, 3); DSA_SB();
    DSA_MM(aB, 5); DSA_SB(); DSA_VA(aA, 4); DSA_SB();
    DSA_MM(aA, 6); DSA_SB(); DSA_VA(aB, 5); DSA_SB();
    DSA_MM(aB, 7); DSA_SB(); DSA_VA(aA, 6); DSA_SB();
    asm volatile("s_nop 7\n\ts_nop 7" ::: "memory");
    DSA_VA(aB, 7); DSA_SB();
#undef DSA_SB
    float x[16];
#pragma unroll
    for (int b_ = 0; b_ < 4; ++b_) { x[4 * b_] = xa[b_][0]; x[4 * b_ + 1] = xa[b_][1]; x[4 * b_ + 2] = xa[b_][2]; x[4 * b_ + 3] = xa[b_][3]; }
    __builtin_amdgcn_sched_barrier(0);
    if (kb + 63 > t0) dsa_classify<MODE, true>(L, x, dl, kb, tq, qloc, wid, lane); else dsa_classify<MODE, false>(L, x, dl, kb, tq, qloc, wid, lane);
    __builtin_amdgcn_sched_barrier(0);
}
#define DSA_LOADK(buf, grp) do { const GAS bf16_t* kp_ = Pb + (size_t)(64 * (grp) + i16) * 64 + 8 * g4; \
    _Pragma("unroll") for (int blk_ = 0; blk_ < 4; ++blk_) { buf[blk_][0] = *(const GAS bf16x8*)(kp_ + (size_t)(16 * blk_) * 64); buf[blk_][1] = *(const GAS bf16x8*)(kp_ + (size_t)(16 * blk_) * 64 + 32); } } while (0)
template <int MODE>
__device__ __forceinline__ void dsa_pass(LAS unsigned char* L, const bf16_t* Pb_, const bf16x8 (&qf)[9][2], const float (&wh)[8], int t0_, int wid, int lane_, bool dry = false, int gstep = 4) {
    const GAS bf16_t* Pb = (const GAS bf16_t*)Pb_; int t0 = t0_, lane = lane_;
    asm volatile("" : "+s"(Pb), "+s"(t0), "+v"(lane));
    const int i16 = lane & 15, g4 = lane >> 4, qh = wid >> 2, kslot = wid & 3;
    const int qloc = 16 * qh + i16, tq = t0 + qloc, T = t0 + 32;
    const DsaPrm pr = dsa_prm(L);
    DsaLane dl; dl.sc0 = pr.sc0[qloc]; dl.off0 = pr.off0[qloc]; dl.sc1 = pr.sc1[qloc]; dl.off1 = pr.off1[qloc]; dl.b0 = dry ? -1 : pr.b0[qloc]; dl.b1 = pr.b1[qloc];
    const int ngroups = (T + 63) >> 6, glast = ngroups - 1;
    bf16x8 kf[4][2], kn[4][2];
    int g = kslot;
    DSA_LOADK(kf, min(g, glast));
#pragma unroll 1
    while (g < ngroups) {
        DSA_LOADK(kn, min(g + gstep, glast));
        __builtin_amdgcn_sched_barrier(0);
        dsa_group<MODE>(L, kf, qf, wh, dl, 64 * g, t0, tq, qloc, wid, lane);
        g += gstep;
        if (g >= ngroups) break;
        DSA_LOADK(kf, min(g + gstep, glast));
        __builtin_amdgcn_sched_barrier(0);
        dsa_group<MODE>(L, kn, qf, wh, dl, 64 * g, t0, tq, qloc, wid, lane);
        g += gstep;
    }
}
__device__ __forceinline__ void dsa_binsearch(LAS unsigned char* L, LAS int* bout, int level) {
    const int tid = opaque_tid(), lane = tid & 63, q = tid >> 4, sub = tid & 15;
    const DsaPrm pr = dsa_prm(L);
    LAS const unsigned* hist = (LAS const unsigned*)(L + L_H) + q * 1024;
    int s = 0;
#pragma unroll
    for (int i = 0; i < 16; ++i) { const u32x4 h4 = *(LAS const u32x4*)(hist + 64 * sub + 4 * ((i + lane) & 15)); s += (int)((h4.x + h4.y) + (h4.z + h4.w)); }
    pr.part[q * 16 + sub] = s;
    __syncthreads();
    if (sub == 0) {
        const int k = pr.krem[q]; int acc = 0, c = 0;
        { u32x4 pp[4];
#pragma unroll
          for (int i = 0; i < 4; ++i) pp[i] = *(LAS const u32x4*)(pr.part + q * 16 + 4 * i);
          bool dn = false;
#pragma unroll
          for (int cc = 15; cc >= 1; --cc) { const int p = (int)pp[cc >> 2][cc & 3]; const bool hit = !dn && (acc + p >= k); c = hit ? cc : c; dn = dn || hit; acc += dn ? 0 : p; } }
        int j = 0;
        { u32x4 hb[16];
#pragma unroll
          for (int i = 0; i < 16; ++i) hb[i] = *(LAS const u32x4*)(hist + 64 * c + 4 * i);
          bool dn = false;
#pragma unroll
          for (int jj = 63; jj >= 1; --jj) { const int v = (int)hb[jj >> 2][jj & 3]; const bool hit = !dn && (acc + v >= k); j = hit ? jj : j; dn = dn || hit; acc += dn ? 0 : v; } }
        const int bb = 64 * c + j; const int cin = (int)hist[bb];
        bout[q] = bb; pr.cin[q] = cin; pr.krem[q] = k - acc;
        if (level == 0) {
            const float sc0 = pr.sc0[q], off0 = pr.off0[q];
            const float sc1 = sc0 * 1024.f; pr.sc1[q] = sc1; pr.off1[q] = (off0 - (float)bb) * 1024.f;
            if (cin > DSA_CAP) pr.flag[0] = 1;
        }
    }
    __syncthreads();
}
__device__ __forceinline__ void dsa_zero_hist(LAS unsigned char* L) {
    const int tid = opaque_tid();
    const u32x4 z4 = opaque_splat(0u);
#pragma unroll
    for (int i = 0; i < 16; ++i) *(LAS u32x4*)(L + L_H + (i * 512 + tid) * 16) = z4;
}
constexpr int DSA_VS = 144;
__device__ __forceinline__ void dsa_unit(LAS unsigned char* L, const bf16_t* P, const bf16_t* IKC, const bf16_t* DKV, bf16_t* MIX, const unsigned* kmaxw, int b, int qt) {
    const int tid = opaque_tid(), lane = tid & 63, wid = __builtin_amdgcn_readfirstlane(tid >> 6), r32 = lane & 31, hi = lane >> 5;
    const size_t rowbase = (size_t)b * SEQ; const int t0 = qt * 32;
    const bf16_t* Pb = P + rowbase * NP;
    const bf16_t* IKb = IKC + rowbase * 64; const bf16_t* DKVb = DKV + rowbase * 128;
    const DsaPrm pr = dsa_prm(L);
    LAS unsigned short* selall = (LAS unsigned short*)(L + L_SEL);
    if (qt < 8) {
        for (int i = tid; i < 32 * 256; i += NTHREADS) selall[i] = (unsigned short)(((i & 255) <= t0 + (i >> 8)) ? (i & 255) : 0xFFFF);
        if (tid < 32) pr.nsel[tid] = (unsigned)(t0 + tid + 1);
        __syncthreads();
    } else {
        bf16x8 qf[9][2]; float wh[8];
        const int i16q = lane & 15, g4q = lane >> 4, qh = wid >> 2, qloc = 16 * qh + i16q;
        float Rloc = 0.f;
        float kmx_pre = 0.f;
        { const bf16_t* qp = Pb + (size_t)(t0 + qloc) * NP + C_IQ + 8 * g4q;
          const u32x4 wv = *(const u32x4*)(Pb + (size_t)(t0 + qloc) * NP + C_IW);
          u32x4 qraw[8][2];
#pragma unroll
          for (int h = 0; h < 8; ++h)
#pragma unroll
              for (int ks = 0; ks < 2; ++ks) qraw[h][ks] = *(const u32x4*)(qp + h * 64 + 32 * ks);
          if (tid < 32) kmx_pre = sqrtf(__uint_as_float(kmaxw[64 * b]) + __uint_as_float(kmaxw[64 * b + 1]));
          __builtin_amdgcn_sched_barrier(0);
          if (t0 + 32 >= 2048) {
              dsa_zero_hist(L);
              const u32x4 z4 = opaque_splat(0u); for (int i = tid; i < 16384 / 16; i += NTHREADS) ((LAS u32x4*)(L + L_SEL))[i] = z4; }
          __builtin_amdgcn_sched_barrier(0);
          const float wr[8] = {bf_lo(wv.x), bf_hi(wv.x), bf_lo(wv.y), bf_hi(wv.y), bf_lo(wv.z), bf_hi(wv.z), bf_lo(wv.w), bf_hi(wv.w)};
          float qs[2][8];
#pragma unroll
          for (int ks = 0; ks < 2; ++ks)
#pragma unroll
              for (int j = 0; j < 8; ++j) qs[ks][j] = 0.f;
          float rsum = 0.f;
#pragma unroll
          for (int h = 0; h < 8; ++h) { wh[h] = (wr[h] < 0.f) ? -1.f : 1.f; float ss = 0.f;
#pragma unroll
              for (int ks = 0; ks < 2; ++ks) { const u32x4 u = qraw[h][ks];
                  float v[8] = {bf_lo(u.x), bf_hi(u.x), bf_lo(u.y), bf_hi(u.y), bf_lo(u.z), bf_hi(u.z), bf_lo(u.w), bf_hi(u.w)};
#pragma unroll
                  for (int j = 0; j < 8; ++j) { v[j] *= wr[h]; qs[ks][j] += v[j]; }
                  const bf16x8 pk = pack8(v[0], v[1], v[2], v[3], v[4], v[5], v[6], v[7]); qf[h][ks] = pk;
                  const u32x4 pu = __builtin_bit_cast(u32x4, pk);
                  ss += bf_lo(pu.x) * bf_lo(pu.x) + bf_hi(pu.x) * bf_hi(pu.x) + bf_lo(pu.y) * bf_lo(pu.y) + bf_hi(pu.y) * bf_hi(pu.y) + bf_lo(pu.z) * bf_lo(pu.z) + bf_hi(pu.z) * bf_hi(pu.z) + bf_lo(pu.w) * bf_lo(pu.w) + bf_hi(pu.w) * bf_hi(pu.w); }
              ss += __shfl_xor(ss, 16); ss += __shfl_xor(ss, 32);
              rsum += sqrtf(ss); }
          float ss = 0.f;
#pragma unroll
          for (int ks = 0; ks < 2; ++ks) { const bf16x8 pk = pack8(qs[ks][0], qs[ks][1], qs[ks][2], qs[ks][3], qs[ks][4], qs[ks][5], qs[ks][6], qs[ks][7]); qf[8][ks] = pk;
              const u32x4 pu = __builtin_bit_cast(u32x4, pk);
              ss += bf_lo(pu.x) * bf_lo(pu.x) + bf_hi(pu.x) * bf_hi(pu.x) + bf_lo(pu.y) * bf_lo(pu.y) + bf_hi(pu.y) * bf_hi(pu.y) + bf_lo(pu.z) * bf_lo(pu.z) + bf_hi(pu.z) * bf_hi(pu.z) + bf_lo(pu.w) * bf_lo(pu.w) + bf_hi(pu.w) * bf_hi(pu.w); }
          ss += __shfl_xor(ss, 16); ss += __shfl_xor(ss, 32);
          Rloc = rsum + sqrtf(ss); }
        if ((wid & 3) == 0 && g4q == 0) pr.part[qloc] = __float_as_int(Rloc);
        __syncthreads();
        float Rb = 1.f;
        if (tid < 32) Rb = fmaxf(__int_as_float(pr.part[tid]) * kmx_pre * 1.01f, 1e-30f);
#pragma unroll 1
        for (int rep_sel = 0; rep_sel < REP_DSEL; ++rep_sel) {
        __syncthreads();
        if (tid < 32) {
            pr.sc0[tid] = 512.f / Rb; pr.off0[tid] = 512.f; pr.sc1[tid] = 0.f; pr.off1[tid] = 0.f; pr.b0[tid] = 0; pr.b1[tid] = 0; pr.krem[tid] = 256; pr.nsel[tid] = 0u; pr.ncand[tid] = 0u;
            if (tid == 0) pr.flag[0] = 0;
        }
        bool done_sel = false;
        if (t0 + 32 >= 2048) {
            if (tid < 32) pr.sc0[tid] = 2048.f / Rb;
            __syncthreads();
            dsa_pass<0>(L, IKb, qf, wh, t0, wid, lane, false, 16);
            __syncthreads();
            if (tid < 32) pr.krem[tid] = DSL_KS;
            __syncthreads();
            dsa_binsearch(L, pr.b0, 2);
            if (tid < 32) { pr.ncand[tid] = 0u; pr.krem[tid] = 256; }
            if (tid == 0) pr.flag[0] = 0;
            __syncthreads();
            dsa_pass<3>(L, IKb, qf, wh, t0, wid, lane);
            __syncthreads();
            {
                const int q = tid >> 4, sub = tid & 15;
                LAS unsigned* wh_ = (LAS unsigned*)(L + L_SEL) + q * 128;
                { const int n = min((int)pr.ncand[q], DSL_CAP), bf = pr.b0[q]; const float sc0 = pr.sc0[q], off0 = pr.off0[q];
                  LAS const float* ls = (LAS const float*)(L + L_H) + q * DSL_CAP;
#pragma unroll 1
                  for (int i = sub; i < n; i += 64) {
                      float xs4[4];
#pragma unroll
                      for (int u = 0; u < 4; ++u) xs4[u] = ls[min(i + 16 * u, DSL_CAP - 1)];
#pragma unroll
                      for (int u = 0; u < 4; ++u) if (i + 16 * u < n) { int bin = (int)__builtin_fmaf(xs4[u], sc0, off0); bin = min(max(bin, 0), 1023); __hip_atomic_fetch_add(wh_ + min(bin - bf, 127), 1u, __ATOMIC_RELAXED, __HIP_MEMORY_SCOPE_WORKGROUP); } } }
                __syncthreads();
                int sacc = 0;
#pragma unroll
                for (int i = 0; i < 8; ++i) sacc += (int)wh_[8 * sub + i];
                pr.part[q * 16 + sub] = sacc;
                __syncthreads();
                if (sub == 0) { int acc = 0, c = 0, j = 0;
                    { u32x4 pp[4];
#pragma unroll
                      for (int i = 0; i < 4; ++i) pp[i] = *(LAS const u32x4*)(pr.part + q * 16 + 4 * i);
                      bool dn = false;
#pragma unroll
                      for (int cc = 15; cc >= 1; --cc) { const int p = (int)pp[cc >> 2][cc & 3]; const bool hit = !dn && (acc + p >= 256); c = hit ? cc : c; dn = dn || hit; acc += dn ? 0 : p; } }
                    { u32x4 hb[2];
#pragma unroll
                      for (int i = 0; i < 2; ++i) hb[i] = *(LAS const u32x4*)(wh_ + 8 * c + 4 * i);
                      bool dn = false;
#pragma unroll
                      for (int jj = 7; jj >= 1; --jj) { const int v = (int)hb[jj >> 2][jj & 3]; const bool hit = !dn && (acc + v >= 256); j = hit ? jj : j; dn = dn || hit; acc += dn ? 0 : v; } }
                    const int b0w = 8 * c + j; const int tot = acc + (int)wh_[b0w];
                    pr.b1[q] = b0w; pr.krem[q] = 256 - acc;
                    if (tot < 256 || b0w >= 127 || pr.ncand[q] > (unsigned)DSL_CAP) pr.flag[0] = 1; }
                __syncthreads();
            }
            if (pr.flag[0] == 0) {
                done_sel = true;
                const int q = tid >> 4, sub = tid & 15;
                const int n = (int)pr.ncand[q], bf = pr.b0[q], b0w = pr.b1[q], k = pr.krem[q];
                const float sc0 = pr.sc0[q], off0 = pr.off0[q];
                const float fs = sc0 * 128.f, fo = (off0 - (float)(bf + b0w)) * 128.f;
                LAS const float* ls = (LAS const float*)(L + L_H) + q * DSL_CAP; LAS const unsigned short* lk = (LAS const unsigned short*)(L + L_H + 65536) + q * DSL_CAP;
                LAS unsigned* sh = (LAS unsigned*)(L + L_SEL) + q * 128;
                LAS unsigned* bmq = (LAS unsigned*)(L + L_H + 98304) + q * 256;
                __syncthreads();
                { const u32x4 z4 = opaque_splat(0u); for (int i = tid; i < 32768 / 16; i += NTHREADS) ((LAS u32x4*)(L + L_H + 98304))[i] = z4;
#pragma unroll
                  for (int i = 0; i < 2; ++i) *(LAS u32x4*)(sh + 8 * sub + 4 * i) = z4; }
                if (sub == 0) pr.cin[q] = 0;
                __syncthreads();
#pragma unroll 1
                for (int i = sub; i < n; i += 64) {
                    float xs4[4]; unsigned ks4[4];
#pragma unroll
                    for (int u = 0; u < 4; ++u) { const int ii = min(i + 16 * u, DSL_CAP - 1); xs4[u] = ls[ii]; ks4[u] = lk[ii]; }
#pragma unroll
                    for (int u = 0; u < 4; ++u) if (i + 16 * u < n) { const float xv = xs4[u]; int bin = (int)__builtin_fmaf(xv, sc0, off0); bin = min(max(bin, 0), 1023); const int w = min(bin - bf, 127);
                        if (w > b0w) { const unsigned ki = ks4[u]; __hip_atomic_fetch_or(bmq + (ki >> 5), 1u << (ki & 31u), __ATOMIC_RELAXED, __HIP_MEMORY_SCOPE_WORKGROUP); }
                        else if (w == b0w) { int c = (int)__builtin_fmaf(xv, fs, fo); c = min(max(c, 0), 127); __hip_atomic_fetch_add(sh + c, 1u, __ATOMIC_RELAXED, __HIP_MEMORY_SCOPE_WORKGROUP); } } }
                __syncthreads();
                { int sacc = 0;
#pragma unroll
                  for (int i = 0; i < 8; ++i) sacc += (int)sh[8 * sub + i];
                  pr.part[q * 16 + sub] = sacc; }
                __syncthreads();
                if (sub == 0) { int acc = 0, c = 0, j = 0;
                    { u32x4 pp[4];
#pragma unroll
                      for (int i = 0; i < 4; ++i) pp[i] = *(LAS const u32x4*)(pr.part + q * 16 + 4 * i);
                      bool dn = false;
#pragma unroll
                      for (int cc = 15; cc >= 1; --cc) { const int p = (int)pp[cc >> 2][cc & 3]; const bool hit = !dn && (acc + p >= k); c = hit ? cc : c; dn = dn || hit; acc += dn ? 0 : p; } }
                    { u32x4 hb[2];
#pragma unroll
                      for (int i = 0; i < 2; ++i) hb[i] = *(LAS const u32x4*)(sh + 8 * c + 4 * i);
                      bool dn = false;
#pragma unroll
                      for (int jj = 7; jj >= 1; --jj) { const int v = (int)hb[jj >> 2][jj & 3]; const bool hit = !dn && (acc + v >= k); j = hit ? jj : j; dn = dn || hit; acc += dn ? 0 : v; } }
                    pr.b1[q] = 8 * c + j; pr.krem[q] = k - acc; }
                __syncthreads();
                const int b2 = pr.b1[q], k2 = pr.krem[q];
                LAS unsigned short* tie = (LAS unsigned short*)sh;
                __syncthreads();
#pragma unroll 1
                for (int i = sub; i < n; i += 64) {
                    float xs4[4]; unsigned ks4[4];
#pragma unroll
                    for (int u = 0; u < 4; ++u) { const int ii = min(i + 16 * u, DSL_CAP - 1); xs4[u] = ls[ii]; ks4[u] = lk[ii]; }
#pragma unroll
                    for (int u = 0; u < 4; ++u) if (i + 16 * u < n) { const float xv = xs4[u]; int bin = (int)__builtin_fmaf(xv, sc0, off0); bin = min(max(bin, 0), 1023);
                        if (min(bin - bf, 127) == b0w) { int c = (int)__builtin_fmaf(xv, fs, fo); c = min(max(c, 0), 127);
                            if (c > b2) { const unsigned ki = ks4[u]; __hip_atomic_fetch_or(bmq + (ki >> 5), 1u << (ki & 31u), __ATOMIC_RELAXED, __HIP_MEMORY_SCOPE_WORKGROUP); }
                            else if (c == b2) { const unsigned pos = __hip_atomic_fetch_add((LAS unsigned*)pr.cin + q, 1u, __ATOMIC_RELAXED, __HIP_MEMORY_SCOPE_WORKGROUP); if (pos < 256u) tie[pos] = (unsigned short)(i + 16 * u); } } } }
                __syncthreads();
                const int nt = min(pr.cin[q], 256);
#pragma unroll 1
                for (int a = sub; a < nt; a += 16) { const int ia = tie[a]; const float si = ls[ia]; const unsigned ki = lk[ia]; int rank = 0;
#pragma unroll 1
                    for (int bb = 0; bb < nt; ++bb) { const int ib = tie[bb]; const float sj = ls[ib]; const unsigned kj = lk[ib]; rank += (sj > si || (sj == si && kj < ki)) ? 1 : 0; }
                    if (rank < k2) __hip_atomic_fetch_or(bmq + (ki >> 5), 1u << (ki & 31u), __ATOMIC_RELAXED, __HIP_MEMORY_SCOPE_WORKGROUP); }
                __syncthreads();
            }
        }
        if (!done_sel) {
        __syncthreads();
        if (tid < 32) { pr.sc0[tid] = 512.f / Rb; pr.sc1[tid] = 0.f; pr.off1[tid] = 0.f; pr.b0[tid] = 0; pr.b1[tid] = 0; pr.krem[tid] = 256; pr.ncand[tid] = 0u; }
        if (tid == 0) pr.flag[0] = 0;
        __syncthreads();
        for (int pr_ = 0; pr_ < PROBE_DRY; ++pr_) { __syncthreads(); dsa_pass<1>(L, IKb, qf, wh, t0, wid, lane, true); __syncthreads(); }
        for (int pr_ = 0; pr_ < PROBE_HIST; ++pr_) { __syncthreads(); dsa_pass<0>(L, IKb, qf, wh, t0, wid, lane); __syncthreads(); }
        for (int pr_ = 0; pr_ < PROBE_ZERO; ++pr_) { dsa_zero_hist(L); __syncthreads(); __syncthreads(); }
        dsa_zero_hist(L);
        __syncthreads();
        dsa_pass<0>(L, IKb, qf, wh, t0, wid, lane);
        __syncthreads();
        dsa_binsearch(L, pr.b0, 0);
        const bool lvl1 = pr.flag[0] != 0;
        if (lvl1) {
            dsa_zero_hist(L);
            __syncthreads();
            dsa_pass<1>(L, IKb, qf, wh, t0, wid, lane);
            __syncthreads();
            dsa_binsearch(L, pr.b1, 1);
        } else { if (tid < 32) { pr.sc1[tid] = 0.f; pr.off1[tid] = 0.f; pr.b1[tid] = 0; } }
        { const u32x4 z4 = opaque_splat(0u); for (int i = tid; i < 32768 / 16; i += NTHREADS) ((LAS u32x4*)(L + L_H + 98304))[i] = z4; }
        __syncthreads();
        dsa_pass<2>(L, IKb, qf, wh, t0, wid, lane);
        __syncthreads();
        {
            const int q = tid >> 4, sub = tid & 15;
            const int n = min((int)pr.ncand[q], DSA_CAP), k = pr.krem[q];
            LAS const float* cs = (LAS const float*)(L + L_H) + q * DSA_CAP; LAS const unsigned* ck = (LAS const unsigned*)(L + L_H + 32768) + q * DSA_CAP;
            LAS unsigned* sh = (LAS unsigned*)(L + L_H + 65536) + q * 256;
            LAS unsigned short* tie = (LAS unsigned short*)(L + L_SEL) + q * 256;
            LAS unsigned* bmq = (LAS unsigned*)(L + L_H + 98304) + q * 256;
            const float fs = (lvl1 ? pr.sc1[q] : pr.sc0[q]) * 256.f, fo = (lvl1 ? (pr.off1[q] - (float)pr.b1[q]) : (pr.off0[q] - (float)pr.b0[q])) * 256.f;
            { const u32x4 z4 = opaque_splat(0u);
#pragma unroll
            for (int i = 0; i < 4; ++i) *(LAS u32x4*)(sh + 16 * sub + 4 * i) = z4; }
            if (sub == 0) pr.cin[q] = 0;
            __syncthreads();
#pragma unroll 1
            for (int i = sub; i < n; i += 16) { int c = (int)__builtin_fmaf(cs[i], fs, fo); c = min(max(c, 0), 255); __hip_atomic_fetch_add(sh + c, 1u, __ATOMIC_RELAXED, __HIP_MEMORY_SCOPE_WORKGROUP); }
            __syncthreads();
            { int sacc = 0;
#pragma unroll
              for (int i = 0; i < 16; ++i) sacc += (int)sh[16 * sub + i];
              pr.part[q * 16 + sub] = sacc; }
            __syncthreads();
            if (sub == 0) { int acc = 0, c = 15;
#pragma unroll 1
                for (; c > 0; --c) { const int p = pr.part[q * 16 + c]; if (acc + p >= k) break; acc += p; }
                int j = 15;
#pragma unroll 1
                for (; j > 0; --j) { const int v = (int)sh[16 * c + j]; if (acc + v >= k) break; acc += v; }
                pr.b1[q] = 16 * c + j; pr.krem[q] = k - acc; }
            __syncthreads();
            const int b2 = pr.b1[q], k2 = pr.krem[q];
#pragma unroll 1
            for (int i = sub; i < n; i += 16) { int c = (int)__builtin_fmaf(cs[i], fs, fo); c = min(max(c, 0), 255);
                if (c > b2) { const unsigned ki = ck[i]; __hip_atomic_fetch_or(bmq + (ki >> 5), 1u << (ki & 31u), __ATOMIC_RELAXED, __HIP_MEMORY_SCOPE_WORKGROUP); }
                else if (c == b2) { const unsigned pos = __hip_atomic_fetch_add((LAS unsigned*)pr.cin + q, 1u, __ATOMIC_RELAXED, __HIP_MEMORY_SCOPE_WORKGROUP); tie[pos] = (unsigned short)i; } }
            __syncthreads();
            const int nt = pr.cin[q];
#pragma unroll 1
            for (int a = sub; a < nt; a += 16) { const int ia = tie[a]; const float si = cs[ia]; const unsigned ki = ck[ia]; int rank = 0;
#pragma unroll 1
                for (int bb = 0; bb < nt; ++bb) { const int ib = tie[bb]; const float sj = cs[ib]; const unsigned kj = ck[ib]; rank += (sj > si || (sj == si && kj < ki)) ? 1 : 0; }
                if (rank < k2) __hip_atomic_fetch_or(bmq + (ki >> 5), 1u << (ki & 31u), __ATOMIC_RELAXED, __HIP_MEMORY_SCOPE_WORKGROUP); }
        }
        }
        __syncthreads();
        { const u32x4 f4 = opaque_splat(0xFFFFFFFFu); for (int i = tid; i < 32 * 256 / 8; i += NTHREADS) ((LAS u32x4*)selall)[i] = f4; }
        __syncthreads();
        for (int rl_ = 0; rl_ < REP_LIST; ++rl_)
        {
            const int q = tid >> 4, sub = tid & 15;
            LAS const unsigned* bm = (LAS const unsigned*)(L + L_H + 98304) + q * 256 + sub * 16;
            int cnt = 0; unsigned bw[16];
            { u32x4 b4[4];
#pragma unroll
              for (int i = 0; i < 4; ++i) b4[i] = *(LAS const u32x4*)(bm + 4 * i);
#pragma unroll
              for (int i = 0; i < 16; ++i) { bw[i] = b4[i >> 2][i & 3]; cnt += __builtin_popcount(bw[i]); } }
            pr.part[q * 16 + sub] = cnt;
            __syncthreads();
            int off = 0;
#pragma unroll
            for (int i4 = 0; i4 < 4; ++i4) { const u32x4 p4 = *(LAS const u32x4*)(pr.part + q * 16 + 4 * i4);
                off += ((4 * i4 + 0 < sub) ? (int)p4.x : 0) + ((4 * i4 + 1 < sub) ? (int)p4.y : 0) + ((4 * i4 + 2 < sub) ? (int)p4.z : 0) + ((4 * i4 + 3 < sub) ? (int)p4.w : 0); }
            if (sub == 15) pr.nsel[q] = (unsigned)min(off + cnt, 256);
#pragma unroll
            for (int i = 0; i < 16; ++i) { unsigned w = bw[i];
#pragma unroll 1
                while (w) { const int bit = __builtin_ctz(w); w &= w - 1u; if (off < 256) selall[q * 256 + off] = (unsigned short)((sub * 16 + i) * 32 + bit); ++off; } }
        }
        __syncthreads();
        }
    }
    LAS const float* biasT = (LAS const float*)(L + L_BIAS);
    LAS unsigned char* vl = L + L_H + wid * (64 * DSA_VS);
    const int i16 = lane & 15, g4 = lane >> 4;
    const GAS bf16_t* Pg = (const GAS bf16_t*)Pb; const GAS bf16_t* Dg = (const GAS bf16_t*)DKVb;
    bf16x8 kalo[8][2];
#define DSA_LOADKA(dst, qq, kb0) do { LAS const unsigned short* sel_ = selall + (qq) * 256; \
        _Pragma("unroll") for (int kb_ = 0; kb_ < 8; ++kb_) { const int key_ = (int)sel_[16 * ((kb0) + kb_) + i16] & (SEQ - 1);     \
            const GAS bf16_t* kp_ = Dg + (size_t)key_ * 128 + 8 * g4; dst[kb_][0] = *(const GAS bf16x8*)kp_; dst[kb_][1] = *(const GAS bf16x8*)(kp_ + 32); } } while (0)
    DSA_LOADKA(kalo, wid * 4, 0);
    LAS unsigned char* qs = L + L_H + 81920 + wid * 2560;
    { u32x4 qv[3];
#pragma unroll
      for (int i = 0; i < 3; ++i) { const int c = min(lane + 64 * i, 159); qv[i] = *(const GAS u32x4*)(Pg + (size_t)(t0 + 4 * wid + c / 40) * NP + C_DQ + (c % 40) * 8); }
#pragma unroll
      for (int i = 0; i < 3; ++i) if (lane + 64 * i < 160) *(LAS u32x4*)(qs + (lane + 64 * i) * 16) = qv[i]; }
#pragma unroll 1
    for (int qi = 0; qi < 4; ++qi) {
        const int q = wid * 4 + qi, t = t0 + q;
        LAS const unsigned short* sel = selall + q * 256;
        bf16x8 qb0 = {}, qb1 = {};
        if (i16 < 5) { LAS const unsigned char* qp = qs + (qi * 40 + i16 * 8 + g4) * 16; qb0 = *(LAS const bf16x8*)qp; qb1 = *(LAS const bf16x8*)(qp + 64); }
        f32x4 sc[16];
        { bf16x8 kahi[8][2];
          DSA_LOADKA(kahi, q, 8);
          __builtin_amdgcn_sched_barrier(0);
#pragma unroll
          for (int kb = 0; kb < 8; ++kb) { f32x4 acc = {0.f, 0.f, 0.f, 0.f}; acc = mfma16(kalo[kb][0], qb0, acc); acc = mfma16(kalo[kb][1], qb1, acc); sc[kb] = acc; }
#pragma unroll
          for (int kb = 0; kb < 8; ++kb) { f32x4 acc = {0.f, 0.f, 0.f, 0.f}; acc = mfma16(kahi[kb][0], qb0, acc); acc = mfma16(kahi[kb][1], qb1, acc); sc[8 + kb] = acc; } }
        __builtin_amdgcn_sched_barrier(0);
        u32x4 vv[8];
#pragma unroll
        for (int i = 0; i < 8; ++i) { const int key = (int)sel[8 * i + (lane >> 3)] & (SEQ - 1); vv[i] = *(const GAS u32x4*)(Dg + (size_t)key * 128 + 64 + (lane & 7) * 8); }
        float mx = -1e30f;
        const float bfar = biasT[128 * 8 + (i16 & 7)];
        int klast[16];
#pragma unroll
        for (int kb = 0; kb < 16; ++kb) klast[kb] = (int)sel[16 * kb + 15];
        __builtin_amdgcn_sched_barrier(0);
#pragma unroll
        for (int kb = 0; kb < 16; ++kb) {
            if (klast[kb] + 128 <= t) {
#pragma unroll
                for (int r = 0; r < 4; ++r) { const float sv = sc[kb][r] + bfar; sc[kb][r] = sv; mx = fmaxf(mx, sv); }
            } else {
                const u32x2 sk = *(LAS const u32x2*)(sel + 16 * kb + 4 * g4);
                const int keys[4] = {(int)(sk.x & 0xffffu), (int)(sk.x >> 16), (int)(sk.y & 0xffffu), (int)(sk.y >> 16)};
                float bv[4];
#pragma unroll
                for (int r = 0; r < 4; ++r) bv[r] = biasT[min(max(t - keys[r], 0), 128) * 8 + (i16 & 7)];
#pragma unroll
                for (int r = 0; r < 4; ++r) { float sv = sc[kb][r] + bv[r];
                    sv = (keys[r] == 0xFFFF) ? -1e30f : sv;
                    sc[kb][r] = sv; mx = fmaxf(mx, sv); }
            } }
        mx = fmaxf(mx, __shfl_xor(mx, 16)); mx = fmaxf(mx, __shfl_xor(mx, 32));
        float sum = 0.f;
#pragma unroll
        for (int kb = 0; kb < 16; ++kb)
#pragma unroll
            for (int r = 0; r < 4; ++r) { const float p = __builtin_amdgcn_exp2f(sc[kb][r] - mx); sc[kb][r] = p; sum += p; }
        sum += __shfl_xor(sum, 16); sum += __shfl_xor(sum, 32);
        const float inv = 1.f / sum;
        bf16x8 pa[8];
#pragma unroll
        for (int j = 0; j < 8; ++j) pa[j] = pack8(sc[2 * j][0] * inv, sc[2 * j][1] * inv, sc[2 * j][2] * inv, sc[2 * j][3] * inv, sc[2 * j + 1][0] * inv, sc[2 * j + 1][1] * inv, sc[2 * j + 1][2] * inv, sc[2 * j + 1][3] * inv);
        __builtin_amdgcn_sched_barrier(0);
        if (qi < 3) DSA_LOADKA(kalo, q + 1, 0);
        __builtin_amdgcn_sched_barrier(0);
        f32x4 o[4] = {{0.f, 0.f, 0.f, 0.f}, {0.f, 0.f, 0.f, 0.f}, {0.f, 0.f, 0.f, 0.f}, {0.f, 0.f, 0.f, 0.f}};
#pragma unroll
        for (int c = 0; c < 4; ++c) {
#pragma unroll
            for (int i = 0; i < 8; ++i) { const int row = 8 * i + (lane >> 3), ch = lane & 7; *(LAS u32x4*)(vl + row * DSA_VS + ch * 16) = vv[i]; }
            if (c + 1 < 4) {
#pragma unroll
                for (int i = 0; i < 8; ++i) { const int key = (int)sel[64 * (c + 1) + 8 * i + (lane >> 3)] & (SEQ - 1); vv[i] = *(const GAS u32x4*)(Dg + (size_t)key * 128 + 64 + (lane & 7) * 8); }
            }
            asm volatile("s_waitcnt lgkmcnt(0)" ::: "memory");
#pragma unroll
            for (int s2 = 0; s2 < 2; ++s2) {
                LAS const unsigned char* vp = vl + (32 * s2 + 4 * g4 + (i16 >> 2)) * DSA_VS + (4 * (i16 & 3)) * 2;
#pragma unroll
                for (int nb = 0; nb < 4; ++nb) { const bf16x8 vb = cat8(ldtr(vp + nb * 32), ldtr(vp + 16 * DSA_VS + nb * 32)); o[nb] = mfma16(pa[2 * c + s2], vb, o[nb]); }
            }
            asm volatile("s_waitcnt lgkmcnt(0)" ::: "memory");
        }
        bf16_t* orow = MIX + (rowbase + t) * D + 384;
#pragma unroll
        for (int nb = 0; nb < 4; ++nb)
#pragma unroll
            for (int r = 0; r < 4; ++r) { const int head = 4 * g4 + r; if (head < 5) { const unsigned pk = pk_bf16(o[nb][r], 0.f); orow[head * 64 + 16 * nb + i16] = (bf16_t)(pk & 0xffffu); } }
    }
#undef DSA_LOADKA
    __syncthreads();
}

struct Args { const float* in[18]; float* out; unsigned char* ws; };
constexpr int N_MLA = NBATCH * 6 * 32, N_DSA = NBATCH * 256, N_SB = NBATCH * 32 * 5, N_ATT = N_MLA + N_DSA + N_SB;

#define CAS __attribute__((address_space(4)))
#define KARGS(k) const CAS Args* k = (const CAS Args*)__builtin_amdgcn_kernarg_segment_ptr(); asm volatile("" : "+s"(k))
constexpr int CI_IN = 16 * 88, CI_UQ = 6 * 24, CI_UKV = 4 * 24, CI_O = 16 * 32, CI_GU = 16 * 176, CI_DN = 44 * 32, CI_PG = 16 * 32, CI_PP = 4 * 32;
constexpr int CONV_ITEMS = CI_IN + CI_UQ + CI_UKV + CI_O + CI_GU + CI_DN + CI_PG + CI_PP;
constexpr int CONV_PER_UNIT = 16, N_CONVU = (CONV_ITEMS + CONV_PER_UNIT - 1) / CONV_PER_UNIT;
__device__ __forceinline__ void conv_layer_item(const CAS Args* ka, int ly, int r, LAS float* scr) {
    unsigned char* wl = ka->ws + WS_W + (size_t)ly * LAYER_W_BYTES;
    if (r < CI_IN) { MapIn mp{ka->in[2] + (size_t)ly * D * DIN}; conv_item(mp, 1024, (bf16_t*)(wl + W_IN), scr, r, 88, ka->in[3] + ly * D); return; } r -= CI_IN;
    if (r < CI_UQ) { MapUq mp{ka->in[5] + (size_t)ly * 384 * 576}; conv_item(mp, 384, (bf16_t*)(wl + W_UQ), scr, r, 24, ka->in[4] + ly * 384); return; } r -= CI_UQ;
    if (r < CI_UKV) { MapUkv mp{ka->in[7] + (size_t)ly * 256 * 768}; conv_item(mp, 256, (bf16_t*)(wl + W_UKV), scr, r, 24, ka->in[6] + ly * 256); return; } r -= CI_UKV;
    if (r < CI_O) { MapId mp{ka->in[9] + (size_t)ly * D * D, D}; conv_item(mp, 1024, (bf16_t*)(wl + W_O), scr, r, 32); return; } r -= CI_O;
    if (r < CI_GU) { MapGu mp{ka->in[11] + (size_t)ly * D * DFF, ka->in[12] + (size_t)ly * D * DFF}; conv_item(mp, 1024, (bf16_t*)(wl + W_GU), scr, r, 176, ka->in[10] + ly * D); return; } r -= CI_GU;
    if (r < CI_DN) { MapId mp{ka->in[13] + (size_t)ly * DFF * D, D}; conv_item(mp, 2816, (bf16_t*)(wl + W_DN), scr, r, 32); return; } r -= CI_DN;
    if (r < CI_PG) { MapId mp{ka->in[15] + (size_t)ly * D * D, D}; conv_item(mp, 1024, (bf16_t*)(wl + W_PG), scr, r, 32, ka->in[14] + ly * D); return; } r -= CI_PG;
    { MapId mp{ka->in[16] + (size_t)ly * PLE * D, D}; conv_item(mp, 256, (bf16_t*)(wl + W_PP), scr, r, 32); }
}
__global__ void __launch_bounds__(NTHREADS, 2) mk_fwd(Args a_unused) {
    extern __shared__ __attribute__((aligned(16))) unsigned char lds_raw[];
    LAS unsigned char* L = (LAS unsigned char*)lds_raw;
    const int tid = threadIdx.x, lane = tid & 63, wid = __builtin_amdgcn_readfirstlane(tid >> 6);
    const int G = gridDim.x, bx = blockIdx.x;
    const int gw = bx * NWAVES + wid, ngw = G * NWAVES;
    volatile LAS unsigned* MISC = (volatile LAS unsigned*)(L + L_MISC);
    for (int u = tid; u < (LDS_BYTES - L_PRM) / 4; u += NTHREADS) ((LAS unsigned*)(L + L_PRM))[u] = 0u;
    {
        KARGS(ka);
        LAS float* biasT = (LAS float*)(L + L_BIAS);
        const float* rel_bias = ka->in[8];
        for (int i = tid; i < 129 * 8; i += NTHREADS) { const int d = i >> 3, h = i & 7; int bucket;
            if (d < 16) bucket = d; else { bucket = 16 + (int)(logf((float)d / 16.f) / logf(8.f) * 16.f); bucket = min(bucket, 31); }
            biasT[i] = (h < 5) ? rel_bias[bucket * 5 + h] * LOG2E : 0.f; }
    }
    __syncthreads();
    XcdBarrier bar;
    { KARGS(ka); bar = xcd_barrier_post((unsigned*)(ka->ws + WS_CTL) + CW_BAR, MISC); }

    {
        KARGS(ka);
        LAS float* scr = (LAS float*)(L + L_H + wid * 16384);
        for (int it = gw; it < CONV_ITEMS; it += ngw) conv_layer_item(ka, 0, it, scr);
    }
    { KARGS(ka); x_to_h_rows(ka->in[0], (bf16_t*)(ka->ws + WS_HA), (float*)(ka->ws + WS_SS + 2 * SS_BYTES), gw, ngw); }
    xcd_barrier(bar);

    for (int ly = 0; ly < DEPTH; ++ly) {
#define HCUR(ka) ((bf16_t*)((ly & 1) ? (unsigned char*)(ka)->out : (ka)->ws + WS_HA))
#define HNXT(ka) ((bf16_t*)((ly & 1) ? (ka)->ws + WS_HA : (unsigned char*)(ka)->out))
#define MIXB(ka) ((bf16_t*)((unsigned char*)(ka)->out + (size_t)M * D * 2))
#define SSP(ka, i) ((float*)((ka)->ws + WS_SS + (size_t)(i) * SS_BYTES))
        { KARGS(ka); unsigned char* ws = ka->ws; const unsigned char* wl = ws + WS_W + (size_t)ly * LAYER_W_BYTES;
          pg8::Gemm g{HCUR(ka), (const bf16_t*)(wl + W_IN), M, NP, 1024, 1024, 1024}; pg8::StaticOrder S; S.init(M, NP, G, bx);
          pg8::EpiInProj E{(bf16_t*)(ws + WS_P), SSP(ka, 2), (float*)(ws + WS_SSN), (bf16_t*)(ws + WS_KR), (bf16_t*)(ws + WS_IKC), (bf16_t*)(ws + WS_DKV), (unsigned*)(ws + WS_CTL) + CW_KMAX + 64 * 4 * ly};
          for (int rep = 0; rep < REP_GEMM; ++rep) pg8::gemm_phase(L + L_H, g, S, E);
          const int nfull = ((M / 256) * (NP / 256)) % G;
          if (nfull == 0) cvt_p_rows(ka->in[1] + (size_t)ly * M * PLE, (bf16_t*)(ws + WS_PB), bx * NTHREADS, G * NTHREADS);
          else if (bx >= nfull) cvt_p_rows(ka->in[1] + (size_t)ly * M * PLE, (bf16_t*)(ws + WS_PB), (bx - nfull) * NTHREADS, (G - nfull) * NTHREADS); }
        xcd_barrier(bar);
        { KARGS(ka); unsigned char* ws = ka->ws; const unsigned char* wl = ws + WS_W + (size_t)ly * LAYER_W_BYTES;
          pg8::Gemm g{(const bf16_t*)(ws + WS_P) + C_CQ, (const bf16_t*)(wl + W_UQ), M, 768, 384, NP, 384}; pg8::StaticOrder S; S.init(M, 768, G, bx);
          pg8::EpiUq E{(bf16_t*)(ws + WS_QM), (const float*)(ws + WS_SSN)}; pg8::gemm_phase(L + L_H, g, S, E); }
        { KARGS(ka); unsigned char* ws = ka->ws; const unsigned char* wl = ws + WS_W + (size_t)ly * LAYER_W_BYTES;
          pg8::Gemm g{(const bf16_t*)(ws + WS_P) + C_CKV, (const bf16_t*)(wl + W_UKV), M, 768, 256, NP, 256}; pg8::StaticOrder S; S.init(M, 768, G, (bx + G / 2) % G);
          pg8::EpiBf16 E{(bf16_t*)(ws + WS_KV), KV_LD, KV_LD, (const float*)(ws + WS_SSN), 2}; pg8::gemm_phase(L + L_H, g, S, E); }
        xcd_barrier(bar);
        {
            bool first_unit = true;
            for (;;) {
                KARGS(ka); unsigned char* ws = ka->ws;
                int u;
                if (first_unit) { u = bx; first_unit = false; }
                else {
                    if (tid == 0) MISC[4] = atomicAdd((unsigned*)(ws + WS_CTL) + CW_Q + 64 * ly, 1u) + (unsigned)G;
                    __syncthreads();
                    u = (int)MISC[4];
                    __syncthreads(); }
                if (u >= N_ATT + ((ly + 1 < DEPTH) ? N_CONVU : 0)) break;
                if (u >= N_ATT) {
                    LAS float* scr = (LAS float*)(L + L_H + wid * 16384);
                    for (int j = 0; j < CONV_PER_UNIT / NWAVES; ++j) { const int it = (u - N_ATT) * CONV_PER_UNIT + j * NWAVES + wid; if (it < CONV_ITEMS) conv_layer_item(ka, ly + 1, it, scr); }
                    __syncthreads();
                }
                else if (u < N_MLA) { const int qt = 31 - u / 24, bh = u % 24; for (int rep = 0; rep < REP_MLA; ++rep) mla_unit(L + L_H, (const bf16_t*)(ws + WS_QM), (const bf16_t*)(ws + WS_KV), (const bf16_t*)(ws + WS_KR), MIXB(ka), bh / 6, bh % 6, qt); }
                else if (u < N_MLA + N_DSA) { const int v = u - N_MLA; for (int rep = 0; rep < REP_DSA; ++rep) dsa_unit(L, (const bf16_t*)(ws + WS_P), (const bf16_t*)(ws + WS_IKC), (const bf16_t*)(ws + WS_DKV), MIXB(ka), (const unsigned*)(ws + WS_CTL) + CW_KMAX + 64 * 4 * ly, v & 3, 255 - (v >> 2)); }
                else { const int v = u - N_MLA - N_DSA; const int h = v % 5, r = v / 5; for (int rep = 0; rep < REP_SB; ++rep) { sb_unit(L + L_H, (const bf16_t*)(ws + WS_P), MIXB(ka), r & 3, r >> 2, h); __syncthreads(); } }
            }
        }
        xcd_barrier(bar);
        { KARGS(ka); unsigned char* ws = ka->ws; const unsigned char* wl = ws + WS_W + (size_t)ly * LAYER_W_BYTES;
          pg8::Gemm g{MIXB(ka), (const bf16_t*)(wl + W_O), M, D, 1024, 1024, 1024}; pg8::StaticOrder S; S.init(M, D, G, bx);
          pg8::EpiResid E{HCUR(ka), SSP(ka, 0)}; pg8::gemm_phase(L + L_H, g, S, E); }
        xcd_barrier(bar);
        { KARGS(ka); unsigned char* ws = ka->ws; const unsigned char* wl = ws + WS_W + (size_t)ly * LAYER_W_BYTES;
          pg8::Gemm g{HCUR(ka), (const bf16_t*)(wl + W_GU), M, 2 * DFF, 1024, 1024, 1024}; pg8::StaticOrder S; S.init(M, 2 * DFF, G, bx);
          pg8::EpiSwiglu E{(bf16_t*)(ws + WS_ACT), SSP(ka, 0)}; for (int rep = 0; rep < REP_GEMM; ++rep) pg8::gemm_phase(L + L_H, g, S, E); }
        { KARGS(ka); unsigned char* ws = ka->ws; const unsigned char* wl = ws + WS_W + (size_t)ly * LAYER_W_BYTES;
          pg8::Gemm g{(const bf16_t*)(ws + WS_PB), (const bf16_t*)(wl + W_PP), M, D, 256, 256, 256}; pg8::StaticOrder S; S.init(M, D, G, bx);
          pg8::EpiBf16 E{(bf16_t*)(ws + WS_PP), D, D, nullptr, 0}; pg8::gemm_phase(L + L_H, g, S, E); }
        xcd_barrier(bar);
        { KARGS(ka); unsigned char* ws = ka->ws; const unsigned char* wl = ws + WS_W + (size_t)ly * LAYER_W_BYTES;
          pg8::Gemm g{(const bf16_t*)(ws + WS_ACT), (const bf16_t*)(wl + W_DN), M, D, DFF, DFF, DFF}; pg8::StaticOrder S; S.init(M, D, G, bx);
          pg8::EpiResid E{HCUR(ka), SSP(ka, 1)}; pg8::gemm_phase(L + L_H, g, S, E); }
        xcd_barrier(bar);
        { KARGS(ka); unsigned char* ws = ka->ws; const unsigned char* wl = ws + WS_W + (size_t)ly * LAYER_W_BYTES;
          pg8::Gemm g{HCUR(ka), (const bf16_t*)(wl + W_PG), M, D, 1024, 1024, 1024}; pg8::StaticOrder S; S.init(M, D, G, bx);
          pg8::EpiPle E{HCUR(ka), HNXT(ka), (const bf16_t*)(ws + WS_PP), SSP(ka, 1), SSP(ka, 2)}; pg8::gemm_phase(L + L_H, g, S, E); }
        xcd_barrier(bar);
    }
    { KARGS(ka); final_norm_rows((const bf16_t*)(ka->ws + WS_HA), ka->in[17], ka->out, gw, ngw); }
}

extern "C" void kernel_launch(void* const* d_in, const int* in_sizes, int n_in, void* d_out, int out_size, void* d_ws, size_t ws_size, hipStream_t stream) {
    static int grid = 0;
    if (grid == 0) {
        if (n_in != 18 || out_size != M * D || ws_size < WS_END) { fprintf(stderr, "kernel_launch: unexpected shapes (n_in %d, out %d, ws %zu); nothing launched\n", n_in, out_size, ws_size); grid = -1; return; }
        int dev = 0, cus = 0, per_cu = 0;
        if (hipGetDevice(&dev) != hipSuccess || hipDeviceGetAttribute(&cus, hipDeviceAttributeMultiprocessorCount, dev) != hipSuccess) { grid = -1; return; }
        if (hipFuncSetAttribute((const void*)mk_fwd, hipFuncAttributeMaxDynamicSharedMemorySize, LDS_BYTES) != hipSuccess) { fprintf(stderr, "kernel_launch: hipFuncSetAttribute failed\n"); grid = -1; return; }
        if (hipOccupancyMaxActiveBlocksPerMultiprocessor(&per_cu, (const void*)mk_fwd, NTHREADS, LDS_BYTES) != hipSuccess || per_cu < 1) { fprintf(stderr, "kernel_launch: occupancy query says %d\n", per_cu); }
        (void)hipGetLastError();
        grid = cus;
    }
    if (grid < 0) return;
    if (hipMemsetAsync((char*)d_ws + WS_CTL, 0, CTL_ZERO_BYTES, stream) != hipSuccess) return;
    Args a{};
    for (int i = 0; i < 18; ++i) a.in[i] = (const float*)d_in[i];
    a.out = (float*)d_out; a.ws = (unsigned char*)d_ws;
    hipLaunchKernelGGL(mk_fwd, dim3(grid), dim3(NTHREADS), LDS_BYTES, stream, a);
}
```

```cpp
#include <hip/hip_runtime.h>
#include <cstdio>
#include <cstdint>

#ifndef PH
#define PH 0xFFFF
#endif
#ifndef REP_MLA
#define REP_MLA 1
#endif
#ifndef REP_DSA
#define REP_DSA 1
#endif
#ifndef REP_SB
#define REP_SB 1
#endif
#ifndef REP_GEMM
#define REP_GEMM 1
#endif
#ifndef REP_ROW
#define REP_ROW 1
#endif
#ifndef REP_DSEL
#define REP_DSEL 1
#endif
#ifndef REP_DATT
#define REP_DATT 1
#endif
#ifndef PROBE_DRY
#define PROBE_DRY 0
#endif
#ifndef PROBE_BAR
#define PROBE_BAR 0
#endif
#ifndef REP_ATTPH
#define REP_ATTPH 1
#endif
#ifndef REP_INPH
#define REP_INPH 1
#endif
#ifndef REP_PREPPH
#define REP_PREPPH 1
#endif
#ifndef REP_UQPH
#define REP_UQPH 1
#endif
#ifndef REP_GUPH
#define REP_GUPH 1
#endif
#ifndef REP_CONV
#define REP_CONV 1
#endif
#ifndef REP_RANK
#define REP_RANK 1
#endif
#ifndef REP_LIST
#define REP_LIST 1
#endif
#ifndef PROBE_HIST
#define PROBE_HIST 0
#endif
#ifndef PROBE_ZERO
#define PROBE_ZERO 0
#endif

#define LAS __attribute__((address_space(3)))
#define GAS __attribute__((address_space(1)))
typedef unsigned short bf16_t;
typedef short bf16x8 __attribute__((ext_vector_type(8)));
typedef short s16x4 __attribute__((ext_vector_type(4)));
typedef float f32x2 __attribute__((ext_vector_type(2)));
typedef float f32x4 __attribute__((ext_vector_type(4)));
typedef float f32x16 __attribute__((ext_vector_type(16)));
typedef unsigned u32x2 __attribute__((ext_vector_type(2)));
typedef unsigned u32x4 __attribute__((ext_vector_type(4)));
typedef __bf16 bf16x2_t __attribute__((ext_vector_type(2)));

constexpr int SEQ = 8192, NBATCH = 4, M = NBATCH * SEQ, D = 1024, DEPTH = 4, DFF = 2816, PLE = 256, DIN = 2664;
constexpr int NP = 2816;
constexpr float EPS = 1e-6f, LOG2E = 1.4426950408889634f;
constexpr int C_CQ = 0, C_CKV = 384, C_KR = 640, C_IW = 672, C_DQ = 704, C_DK = 1024, C_DV = 1088, C_IQ = 1152, C_IK = 1664, C_SQ = 1728, C_SK = 2048, C_SV = 2368;
constexpr int QM_LD = 576, KV_LD = 768, CQN_LD = 640;
constexpr size_t MiB = 1u << 20;
constexpr size_t WS_CTL = 0, CTL_ZERO_BYTES = 1 * MiB;
constexpr size_t W_IN = 0, W_UQ = 5767168, W_UKV = 6356992, W_O = 6750208, W_GU = 8847360, W_DN = 20381696, W_PG = 26148864, W_PP = 28246016, LAYER_W_BYTES = 28770304;
constexpr size_t WS_W = 1 * MiB;
constexpr size_t WS_HA = 112 * MiB, WS_P = 176 * MiB, WS_QM = 352 * MiB, WS_KV = 388 * MiB, WS_KR = 436 * MiB, WS_CQN = 438 * MiB, WS_SSN = 438 * MiB, WS_IKC = 478 * MiB, WS_DKV = 482 * MiB, WS_PB = 490 * MiB, WS_SS = 506 * MiB, WS_END = 512 * MiB;
constexpr size_t WS_ACT = WS_P, WS_PP = WS_KV;
constexpr size_t SS_BYTES = (size_t)M * 16 * 4;
static_assert(WS_W + DEPTH * LAYER_W_BYTES <= WS_HA && WS_SS + 3 * SS_BYTES <= WS_END, "workspace map");
constexpr int CW_BAR = 4096, CW_Q = 8192, CW_KMAX = 9216;
constexpr int L_H = 0, L_SEL = 131072, L_BIAS = 147456, L_PRM = 151680, L_MISC = 155776, LDS_BYTES = 156160;
constexpr int NWAVES = 8, NTHREADS = 512;

__device__ __forceinline__ unsigned pk_bf16(float lo, float hi) { f32x2 v = {lo, hi}; bf16x2_t b = __builtin_convertvector(v, bf16x2_t); return __builtin_bit_cast(unsigned, b); }
__device__ __forceinline__ float bf_lo(unsigned u) { return __uint_as_float(u << 16); }
__device__ __forceinline__ float bf_hi(unsigned u) { return __uint_as_float(u & 0xffff0000u); }
__device__ __forceinline__ float wave_sum(float v) {
#pragma unroll
    for (int o = 1; o < 64; o <<= 1) v += __shfl_xor(v, o);
    return v;
}
__device__ __forceinline__ void rope_coef(int i, float& c_hi, float& c_lo) { const float c = exp2f(-(float)i * 0.83048202372184f) * 0.15915494309189535f; c_hi = __uint_as_float(__float_as_uint(c) & 0xFFFFE000u); c_lo = c - c_hi; }
__device__ __forceinline__ void rope_sc(float pos, float c_hi, float c_lo, float& sn, float& cs) { const float rev = __builtin_amdgcn_fractf(pos * c_hi) + pos * c_lo; sn = __builtin_amdgcn_sinf(rev); cs = __builtin_amdgcn_cosf(rev); }
__device__ __forceinline__ float relu_i(float x) { return __builtin_bit_cast(float, max(__builtin_bit_cast(int, x), 0)); }
__device__ __forceinline__ int opaque_tid() { int t = threadIdx.x; asm volatile("" : "+v"(t)); return t; }
__device__ __forceinline__ u32x4 opaque_splat(unsigned v) { asm volatile("" : "+v"(v)); return (u32x4){v, v, v, v}; }
__device__ __forceinline__ int crow(int r, int hi) { return (r & 3) + 8 * (r >> 2) + 4 * hi; }
__device__ __forceinline__ f32x16 mfma32(bf16x8 a, bf16x8 b, f32x16 c) { return __builtin_amdgcn_mfma_f32_32x32x16_bf16(a, b, c, 0, 0, 0); }
__device__ __forceinline__ f32x4 mfma16(bf16x8 a, bf16x8 b, f32x4 c) { return __builtin_amdgcn_mfma_f32_16x16x32_bf16(a, b, c, 0, 0, 0); }
typedef short v4i16_t __attribute__((ext_vector_type(4)));
__device__ __forceinline__ s16x4 ldtr(LAS const unsigned char* p) { return __builtin_bit_cast(s16x4, __builtin_amdgcn_ds_read_tr16_b64_v4i16((LAS v4i16_t*)p)); }
__device__ __forceinline__ bf16x8 cat8(s16x4 a, s16x4 b) { return (bf16x8){a[0], a[1], a[2], a[3], b[0], b[1], b[2], b[3]}; }
__device__ __forceinline__ bf16x8 pack8(float a0, float a1, float a2, float a3, float a4, float a5, float a6, float a7) {
    u32x4 w; w.x = pk_bf16(a0, a1); w.y = pk_bf16(a2, a3); w.z = pk_bf16(a4, a5); w.w = pk_bf16(a6, a7); return __builtin_bit_cast(bf16x8, w);
}

namespace pg8 {
constexpr int BM = 256, BK = 64, HALF = 128, HTB = HALF * BK * 2, NXCD = 8, WGM = 8;
__host__ __device__ __forceinline__ int lds_byte(int r, int c) { const int st = (r >> 4) * 2 + (c >> 5), rr = r & 15, cc = c & 31, ob = rr * 64 + cc * 2; return st * 1024 + (ob ^ (((ob >> 9) & 1) << 5)); }
__host__ __device__ __forceinline__ void stage_rc(int b, int& R, int& C) { const int st = b / 1024, sb = b % 1024, swz = sb ^ (((sb >> 9) & 1) << 5); R = (st >> 1) * 16 + swz / 64; C = (st & 1) * 32 + (swz % 64) / 2; }
__host__ __device__ __forceinline__ int perm32(int rho) { const int n = rho >> 4, i = rho & 15; return 8 * (i >> 2) + 4 * n + (i & 3); }
struct Unit { int pm, pn; };
struct Gemm { const bf16_t* A; const bf16_t* Bt; int M, N, K, lda, ldb; };
struct StaticOrder {
    int nM, nN, nwg, G, c;
    __device__ void init(int M_, int N_, int G_, int c_) { nM = M_ / BM; nN = N_ / BM; nwg = nM * nN; G = G_; c = c_; }
    __device__ bool next(int i, Unit& u) const {
        const long L = (long)i * G + c; if (L >= nwg) return false;
        int wgid = (int)L; { const int q = nwg / NXCD, r = nwg % NXCD, xcd = wgid % NXCD, off = wgid / NXCD; wgid = (xcd < r ? xcd * (q + 1) : r * (q + 1) + (xcd - r) * q) + off; }
        const int nig = WGM * nN, gid = wgid / nig, fm = gid * WGM, gsz = (nM - fm) < WGM ? (nM - fm) : WGM;
        u.pm = fm + ((wgid % nig) % gsz); u.pn = (wgid % nig) / gsz; return true;
    }
};

template <class Epi>
__device__ __forceinline__ void gemm_phase(LAS unsigned char* lds, const Gemm g, const StaticOrder& S, const Epi& E) {
    const int tid = opaque_tid(), wid = __builtin_amdgcn_readfirstlane(tid >> 6), lane = tid & 63, wr = wid >> 2, wc = wid & 3, fr = lane & 15, fq = lane >> 4;
    const int K = g.K, nt = K / BK;
    unsigned voffA[2], voffB[2];
#pragma unroll
    for (int i = 0; i < 2; ++i) { int R, C; stage_rc(tid * 16 + i * 8192, R, C); const int Rb = (R & ~31) + perm32(R & 31);
        voffA[i] = (unsigned)(R * g.lda + C) * 2u; voffB[i] = (unsigned)(Rb * g.ldb + C) * 2u; }
    const size_t kstep = (size_t)(BK * 2);
    const size_t hstepA = (size_t)HALF * g.lda * 2, hstepB = (size_t)HALF * g.ldb * 2;
    const size_t tstepA = 2 * hstepA, tstepB = 2 * hstepB;
    const unsigned ldsw = (unsigned)wid * 1024u;
    const int aoff = lds_byte(wr * 64 + fr, fq * 8), boff = lds_byte(wc * 32 + fr, fq * 8);
#define PG8_SA(b, h) (((b) * 2 + (h)) * HTB)
#define PG8_SB(b, h) ((4 + (b) * 2 + (h)) * HTB)
#define PG8_STAGE(bufoff, gbase, voff) do { _Pragma("unroll") for (int _i = 0; _i < 2; ++_i) \
        __builtin_amdgcn_global_load_lds((const unsigned*)((const char*)(gbase) + (voff)[_i]), (LAS unsigned*)(lds + (bufoff) + ldsw + _i * 8192), 16, 0, 0); } while (0)
#define PG8_LDA(dst, b, h) do { _Pragma("unroll") for (int m = 0; m < 4; ++m) _Pragma("unroll") for (int k = 0; k < 2; ++k) dst[m][k] = *(const LAS bf16x8*)(lds + PG8_SA(b, h) + aoff + m * 2048 + k * 1024); } while (0)
#define PG8_LDB(dst, b, h) do { _Pragma("unroll") for (int n = 0; n < 2; ++n) _Pragma("unroll") for (int k = 0; k < 2; ++k) dst[n][k] = *(const LAS bf16x8*)(lds + PG8_SB(b, h) + boff + n * 2048 + k * 1024); } while (0)
#define PG8_MMA(ai, bj, At, Bt) do { __builtin_amdgcn_s_setprio(1); _Pragma("unroll") for (int m = 0; m < 4; ++m) _Pragma("unroll") for (int n = 0; n < 2; ++n) _Pragma("unroll") for (int k = 0; k < 2; ++k) \
        acc[ai][bj][m][n] = __builtin_amdgcn_mfma_f32_16x16x32_bf16(Bt[n][k], At[m][k], acc[ai][bj][m][n], 0, 0, 0); __builtin_amdgcn_s_setprio(0); } while (0)
#define PG8_WAIT_V(n) asm volatile("s_waitcnt vmcnt(" #n ")" ::: "memory")
#define PG8_WAIT_L(n) asm volatile("s_waitcnt lgkmcnt(" #n ")" ::: "memory")
#define PG8_BAR __builtin_amdgcn_s_barrier()
#define PG8_SCHED __builtin_amdgcn_sched_barrier(0)
    Unit cur, nxt; int ui = 0;
    if (!S.next(0, cur)) return;
    f32x4 acc[2][2][4][2];
#pragma unroll
    for (int a = 0; a < 2; ++a)
#pragma unroll
        for (int b = 0; b < 2; ++b)
#pragma unroll
            for (int m = 0; m < 4; ++m)
#pragma unroll
                for (int n = 0; n < 2; ++n) acc[a][b][m][n] = (f32x4){0.f, 0.f, 0.f, 0.f};
    bf16x8 At[4][2], B0[2][2], B1[2][2];
    const char* cA = (const char*)g.A + (size_t)cur.pm * tstepA; const char* cB = (const char*)g.Bt + (size_t)cur.pn * tstepB;
    PG8_STAGE(PG8_SB(0, 0), cB, voffB); PG8_STAGE(PG8_SB(0, 1), cB + hstepB, voffB); PG8_STAGE(PG8_SA(0, 0), cA, voffA); PG8_STAGE(PG8_SA(0, 1), cA + hstepA, voffA);
    if (wr == 1) PG8_BAR;
    PG8_WAIT_V(2); PG8_BAR;
    PG8_STAGE(PG8_SB(1, 0), cB + kstep, voffB); PG8_STAGE(PG8_SA(1, 0), cA + kstep, voffA); PG8_STAGE(PG8_SB(1, 1), cB + hstepB + kstep, voffB);
    PG8_WAIT_V(6); PG8_BAR;
    for (;;) {
        const bool has_next = S.next(ui + 1, nxt);
        const char* nA = has_next ? (const char*)g.A + (size_t)nxt.pm * tstepA : cA; const char* nB = has_next ? (const char*)g.Bt + (size_t)nxt.pn * tstepB : cB;
#pragma unroll 1
        for (int t = 0; t < nt; t += 2) {
            const bool last = (t == nt - 2);
            const char* a1 = cA + (size_t)(t + 1) * kstep;
            const char* a2 = last ? nA : cA + (size_t)(t + 2) * kstep; const char* b2 = last ? nB : cB + (size_t)(t + 2) * kstep;
            const char* a3 = a2 + kstep; const char* b3 = b2 + kstep;
            PG8_LDB(B0, 0, 0); PG8_LDB(B1, 0, 1); PG8_SCHED; PG8_LDA(At, 0, 0); PG8_STAGE(PG8_SA(1, 1), a1 + hstepA, voffA);
            PG8_WAIT_V(8); PG8_WAIT_L(0); PG8_BAR; PG8_MMA(0, 0, At, B0); PG8_MMA(0, 1, At, B1); PG8_BAR; PG8_SCHED;
            PG8_LDA(At, 0, 1); PG8_STAGE(PG8_SB(0, 0), b2, voffB); PG8_STAGE(PG8_SB(0, 1), b2 + hstepB, voffB); PG8_STAGE(PG8_SA(0, 0), a2, voffA);
            PG8_WAIT_V(8); PG8_WAIT_L(0); PG8_BAR; PG8_MMA(1, 0, At, B0); PG8_MMA(1, 1, At, B1); PG8_BAR; PG8_SCHED;
            PG8_LDB(B0, 1, 0); PG8_LDB(B1, 1, 1); PG8_SCHED; PG8_LDA(At, 1, 0); PG8_STAGE(PG8_SA(0, 1), a2 + hstepA, voffA);
            PG8_WAIT_V(8); PG8_WAIT_L(0); PG8_BAR; PG8_MMA(0, 0, At, B0); PG8_MMA(0, 1, At, B1); PG8_BAR; PG8_SCHED;
            PG8_LDA(At, 1, 1); PG8_STAGE(PG8_SB(1, 0), b3, voffB); PG8_STAGE(PG8_SB(1, 1), b3 + hstepB, voffB); PG8_STAGE(PG8_SA(1, 0), a3, voffA);
            PG8_WAIT_V(8); PG8_WAIT_L(0); PG8_BAR; PG8_MMA(1, 0, At, B0); PG8_MMA(1, 1, At, B1); PG8_BAR; PG8_SCHED;
        }
        if (wr == 0) PG8_BAR;
        E(acc, cur, wr, wc, fr, fq);
        if (!has_next) break;
#pragma unroll
        for (int a = 0; a < 2; ++a)
#pragma unroll
            for (int b = 0; b < 2; ++b)
#pragma unroll
                for (int m = 0; m < 4; ++m)
#pragma unroll
                    for (int n = 0; n < 2; ++n) acc[a][b][m][n] = (f32x4){0.f, 0.f, 0.f, 0.f};
        cur = nxt; cA = nA; cB = nB; ++ui;
        if (wr == 1) PG8_BAR;
    }
    PG8_WAIT_V(0);
    PG8_BAR;
#undef PG8_SA
#undef PG8_SB
#undef PG8_STAGE
#undef PG8_LDA
#undef PG8_LDB
#undef PG8_MMA
#undef PG8_WAIT_V
#undef PG8_WAIT_L
#undef PG8_BAR
#undef PG8_SCHED
}

typedef const f32x4 (&AccRef)[2][2][4][2];
__device__ __forceinline__ float row_rstd(const float* ss, int row) {
    const f32x4* p = (const f32x4*)(ss + (size_t)row * 16); const f32x4 a = p[0], b = p[1], c = p[2], d = p[3];
    const float t = ((a[0] + a[1]) + (a[2] + a[3])) + ((b[0] + b[1]) + (b[2] + b[3])) + ((c[0] + c[1]) + (c[2] + c[3])) + ((d[0] + d[1]) + (d[2] + d[3]));
    return rsqrtf(t * (1.f / D) + EPS);
}
constexpr int SSN_LD = 32;
__device__ __forceinline__ float row_rstd_q(const float* ssn, int row) {
    const f32x4* p = (const f32x4*)(ssn + (size_t)row * SSN_LD); const f32x4 a = p[0], b = p[1], c = p[2];
    const float t = ((a[0] + a[1]) + (a[2] + a[3])) + ((b[0] + b[1]) + (b[2] + b[3])) + ((c[0] + c[1]) + (c[2] + c[3]));
    return rsqrtf(t * (1.f / 384.f) + EPS);
}
__device__ __forceinline__ float row_rstd_kv(const float* ssn, int row) {
    const f32x4* p = (const f32x4*)(ssn + (size_t)row * SSN_LD + 12); const f32x4 a = p[0], b = p[1];
    const float t = ((a[0] + a[1]) + (a[2] + a[3])) + ((b[0] + b[1]) + (b[2] + b[3]));
    return rsqrtf(t * (1.f / 256.f) + EPS);
}
template <int MODE>
__device__ __forceinline__ void rstd8(const float* ss, int row0, int fq, float (&rs)[8]) {
    f32x4 p[8];
#pragma unroll
    for (int i = 0; i < 8; ++i) { const int row = row0 + (i >> 2) * HALF + (i & 3) * 16; p[i] = (f32x4){0.f, 0.f, 0.f, 0.f};
        if (MODE == 1) p[i] = *(const f32x4*)(ss + (size_t)row * 16 + 4 * fq);
        else if (MODE == 2) p[i] = *(const f32x4*)(ss + (size_t)row * SSN_LD + 4 * min(fq, 2));
        else p[i] = *(const f32x4*)(ss + (size_t)row * SSN_LD + 12 + 4 * (fq & 1)); }
    __builtin_amdgcn_sched_barrier(0);
#pragma unroll
    for (int i = 0; i < 8; ++i) { float t = (p[i][0] + p[i][1]) + (p[i][2] + p[i][3]); if (MODE == 2) t = (fq < 3) ? t : 0.f; if (MODE == 3) t = (fq < 2) ? t : 0.f;
        t += __shfl_xor(t, 16); t += __shfl_xor(t, 32);
        rs[i] = rsqrtf(t * (MODE == 1 ? 1.f / D : MODE == 2 ? 1.f / 384.f : 1.f / 256.f) + EPS); }
}
struct EpiBf16 {
    bf16_t* O; int ldc; int ncols; const float* ss; int mode;
    __device__ __forceinline__ void operator()(AccRef acc, const Unit& u, int wr, int wc, int fr, int fq) const {
        const int row0 = u.pm * BM + wr * 64 + fr;
        float rs8[8];
        if (mode == 2) rstd8<3>(ss, row0, fq, rs8); else {
#pragma unroll
            for (int i = 0; i < 8; ++i) rs8[i] = 1.f; }
#pragma unroll
        for (int ai = 0; ai < 2; ++ai)
#pragma unroll
            for (int m = 0; m < 4; ++m) { const int row = row0 + ai * HALF + m * 16; const float rs = rs8[4 * ai + m];
#pragma unroll
                for (int bj = 0; bj < 2; ++bj) { const int col0 = u.pn * BM + bj * HALF + wc * 32 + 8 * fq; if (col0 >= ncols) continue;
                    const f32x4 v0 = acc[ai][bj][m][0] * rs, v1 = acc[ai][bj][m][1] * rs;
                    u32x4 w; w.x = pk_bf16(v0[0], v0[1]); w.y = pk_bf16(v0[2], v0[3]); w.z = pk_bf16(v1[0], v1[1]); w.w = pk_bf16(v1[2], v1[3]);
                    *(u32x4*)(O + (size_t)row * ldc + col0) = w; } }
    }
};
struct EpiUq {
    bf16_t* O; const float* ssn;
    __device__ __forceinline__ void operator()(AccRef acc, const Unit& u, int wr, int wc, int fr, int fq) const {
        const int row0 = u.pm * BM + wr * 64 + fr;
        float rs8[8]; rstd8<2>(ssn, row0, fq, rs8);
#pragma unroll
        for (int bj = 0; bj < 2; ++bj) { const int col0 = u.pn * BM + bj * HALF + wc * 32 + 8 * fq; if (col0 >= QM_LD) continue;
            const int w = col0 % 96; const bool rope = w >= 64; const int i0 = (w - 64) >> 1;
            float ch[4], cl[4];
#pragma unroll
            for (int p = 0; p < 4; ++p) rope_coef(i0 + p, ch[p], cl[p]);
#pragma unroll
            for (int ai = 0; ai < 2; ++ai)
#pragma unroll
                for (int m = 0; m < 4; ++m) { const int row = row0 + ai * HALF + m * 16; const float rs = rs8[4 * ai + m]; f32x4 v0 = acc[ai][bj][m][0] * rs, v1 = acc[ai][bj][m][1] * rs;
                    if (rope) { const float pos = (float)(row & (SEQ - 1));
                        float s, c;
                        rope_sc(pos, ch[0], cl[0], s, c); { const float x1 = v0[0], x2 = v0[1]; v0[0] = x1 * c - x2 * s; v0[1] = x1 * s + x2 * c; }
                        rope_sc(pos, ch[1], cl[1], s, c); { const float x1 = v0[2], x2 = v0[3]; v0[2] = x1 * c - x2 * s; v0[3] = x1 * s + x2 * c; }
                        rope_sc(pos, ch[2], cl[2], s, c); { const float x1 = v1[0], x2 = v1[1]; v1[0] = x1 * c - x2 * s; v1[1] = x1 * s + x2 * c; }
                        rope_sc(pos, ch[3], cl[3], s, c); { const float x1 = v1[2], x2 = v1[3]; v1[2] = x1 * c - x2 * s; v1[3] = x1 * s + x2 * c; } }
                    u32x4 wv; wv.x = pk_bf16(v0[0], v0[1]); wv.y = pk_bf16(v0[2], v0[3]); wv.z = pk_bf16(v1[0], v1[1]); wv.w = pk_bf16(v1[2], v1[3]);
                    *(u32x4*)(O + (size_t)row * QM_LD + col0) = wv; } }
    }
};
__device__ __forceinline__ float sq8(const u32x4 w) { return (bf_lo(w.x) * bf_lo(w.x) + bf_hi(w.x) * bf_hi(w.x)) + (bf_lo(w.y) * bf_lo(w.y) + bf_hi(w.y) * bf_hi(w.y)) + (bf_lo(w.z) * bf_lo(w.z) + bf_hi(w.z) * bf_hi(w.z)) + (bf_lo(w.w) * bf_lo(w.w) + bf_hi(w.w) * bf_hi(w.w)); }
struct EpiInProj {
    bf16_t* O; const float* ss; float* SSn; bf16_t* KR; bf16_t* IKC; bf16_t* DKV; unsigned* kmaxw;
    __device__ __forceinline__ void operator()(AccRef acc, const Unit& u, int wr, int wc, int fr, int fq) const {
        const int row0 = u.pm * BM + wr * 64 + fr, slab0 = u.pn * 8 + wc;
        float ch[4], cl[4];
        if (slab0 + 4 == 20) {
#pragma unroll
            for (int p = 0; p < 4; ++p) rope_coef(4 * fq + p, ch[p], cl[p]); }
        float kmx = 0.f;
        float rs8[8]; rstd8<1>(ss, row0, fq, rs8);
#pragma unroll
        for (int ai = 0; ai < 2; ++ai)
#pragma unroll
            for (int m = 0; m < 4; ++m) { const int row = row0 + ai * HALF + m * 16; const float rs = rs8[4 * ai + m];
#pragma unroll
                for (int bj = 0; bj < 2; ++bj) { const int slab = slab0 + 4 * bj, col0 = slab * 32 + 8 * fq; if (slab >= 84) continue;
                    f32x4 v0 = acc[ai][bj][m][0] * rs, v1 = acc[ai][bj][m][1] * rs;
                    u32x4 w; w.x = pk_bf16(v0[0], v0[1]); w.y = pk_bf16(v0[2], v0[3]); w.z = pk_bf16(v1[0], v1[1]); w.w = pk_bf16(v1[2], v1[3]);
                    *(u32x4*)(O + (size_t)row * NP + col0) = w;
                    if (slab < 20) { float sq = sq8(w); sq += __shfl_xor(sq, 16); sq += __shfl_xor(sq, 32); if (fq == 0) SSn[(size_t)row * SSN_LD + slab] = sq; }
                    else if (slab == 20) { const float pos = (float)(row & (SEQ - 1)); float s, c;
                        rope_sc(pos, ch[0], cl[0], s, c); { const float x1 = v0[0], x2 = v0[1]; v0[0] = x1 * c - x2 * s; v0[1] = x1 * s + x2 * c; }
                        rope_sc(pos, ch[1], cl[1], s, c); { const float x1 = v0[2], x2 = v0[3]; v0[2] = x1 * c - x2 * s; v0[3] = x1 * s + x2 * c; }
                        rope_sc(pos, ch[2], cl[2], s, c); { const float x1 = v1[0], x2 = v1[1]; v1[0] = x1 * c - x2 * s; v1[1] = x1 * s + x2 * c; }
                        rope_sc(pos, ch[3], cl[3], s, c); { const float x1 = v1[2], x2 = v1[3]; v1[2] = x1 * c - x2 * s; v1[3] = x1 * s + x2 * c; }
                        u32x4 wk; wk.x = pk_bf16(v0[0], v0[1]); wk.y = pk_bf16(v0[2], v0[3]); wk.z = pk_bf16(v1[0], v1[1]); wk.w = pk_bf16(v1[2], v1[3]);
                        *(u32x4*)(KR + (size_t)row * 32 + 8 * fq) = wk; }
                    else if (slab >= 32 && slab < 36) *(u32x4*)(DKV + (size_t)row * 128 + (slab - 32) * 32 + 8 * fq) = w;
                    else if (slab == 52 || slab == 53) { *(u32x4*)(IKC + (size_t)row * 64 + (slab - 52) * 32 + 8 * fq) = w;
                        float sq = sq8(w); sq += __shfl_xor(sq, 16); sq += __shfl_xor(sq, 32); kmx = fmaxf(kmx, sq); } } }
        if (slab0 + 4 == 52 || slab0 + 4 == 53) {
            kmx = fmaxf(kmx, __shfl_xor(kmx, 1)); kmx = fmaxf(kmx, __shfl_xor(kmx, 2)); kmx = fmaxf(kmx, __shfl_xor(kmx, 4)); kmx = fmaxf(kmx, __shfl_xor(kmx, 8));
            if (fr == 0 && fq == 0) atomicMax(kmaxw + 64 * ((u.pm * BM) / SEQ) + (slab0 + 4 - 52), __float_as_uint(kmx)); }
    }
};
struct EpiResid {
    bf16_t* H; float* SSo;
    __device__ __forceinline__ void operator()(AccRef acc, const Unit& u, int wr, int wc, int fr, int fq) const {
        const int row0 = u.pm * BM + wr * 64 + fr;
#pragma unroll
        for (int ai = 0; ai < 2; ++ai) {
            u32x4 hv[4][2];
#pragma unroll
            for (int m = 0; m < 4; ++m)
#pragma unroll
                for (int bj = 0; bj < 2; ++bj) hv[m][bj] = *(const u32x4*)(H + (size_t)(row0 + ai * HALF + m * 16) * D + u.pn * BM + bj * HALF + wc * 32 + 8 * fq);
            __builtin_amdgcn_sched_barrier(0);
#pragma unroll
            for (int m = 0; m < 4; ++m) { const int row = row0 + ai * HALF + m * 16; const size_t ro = (size_t)row * D; float sq = 0.f;
#pragma unroll
                for (int bj = 0; bj < 2; ++bj) { const int col0 = u.pn * BM + bj * HALF + wc * 32 + 8 * fq;
                    const u32x4 h4 = hv[m][bj]; const f32x4 a0 = acc[ai][bj][m][0], a1 = acc[ai][bj][m][1];
                    u32x4 w; w.x = pk_bf16(bf_lo(h4.x) + a0[0], bf_hi(h4.x) + a0[1]); w.y = pk_bf16(bf_lo(h4.y) + a0[2], bf_hi(h4.y) + a0[3]);
                    w.z = pk_bf16(bf_lo(h4.z) + a1[0], bf_hi(h4.z) + a1[1]); w.w = pk_bf16(bf_lo(h4.w) + a1[2], bf_hi(h4.w) + a1[3]);
                    *(u32x4*)(H + ro + col0) = w; sq += sq8(w); }
                sq += __shfl_xor(sq, 16); sq += __shfl_xor(sq, 32);
                if (fq == 0) SSo[(size_t)row * 16 + u.pn * 4 + wc] = sq; } }
    }
};
struct EpiSwiglu {
    bf16_t* O; const float* ss;
    __device__ __forceinline__ void operator()(AccRef acc, const Unit& u, int wr, int wc, int fr, int fq) const {
        const int row0 = u.pm * BM + wr * 64 + fr; const int col0 = u.pn * HALF + wc * 32 + 8 * fq;
        float rs8[8]; rstd8<1>(ss, row0, fq, rs8);
#pragma unroll
        for (int ai = 0; ai < 2; ++ai)
#pragma unroll
            for (int m = 0; m < 4; ++m) { const int row = row0 + ai * HALF + m * 16; const float rs = rs8[4 * ai + m]; float r[8];
#pragma unroll
                for (int n = 0; n < 2; ++n)
#pragma unroll
                    for (int i = 0; i < 4; ++i) { const float gv = acc[ai][0][m][n][i] * rs, uv = acc[ai][1][m][n][i] * rs;
                        r[4 * n + i] = gv * __builtin_amdgcn_rcpf(1.f + __builtin_amdgcn_exp2f(-gv * LOG2E)) * uv; }
                u32x4 w; w.x = pk_bf16(r[0], r[1]); w.y = pk_bf16(r[2], r[3]); w.z = pk_bf16(r[4], r[5]); w.w = pk_bf16(r[6], r[7]);
                *(u32x4*)(O + (size_t)row * DFF + col0) = w; }
    }
};
struct EpiPle {
    const bf16_t* Hin; bf16_t* Hout; const bf16_t* PPb; const float* ss; float* SSo;
    __device__ __forceinline__ void operator()(AccRef acc, const Unit& u, int wr, int wc, int fr, int fq) const {
        const int row0 = u.pm * BM + wr * 64 + fr;
        float rs8[8]; rstd8<1>(ss, row0, fq, rs8);
#pragma unroll
        for (int ai = 0; ai < 2; ++ai)
#pragma unroll
        for (int mp = 0; mp < 2; ++mp) {
            u32x4 pw[2][2], hv[2][2];
#pragma unroll
            for (int mm = 0; mm < 2; ++mm)
#pragma unroll
                for (int bj = 0; bj < 2; ++bj) { const size_t o_ = (size_t)(row0 + ai * HALF + (2 * mp + mm) * 16) * D + u.pn * BM + bj * HALF + wc * 32 + 8 * fq; pw[mm][bj] = *(const u32x4*)(PPb + o_); hv[mm][bj] = *(const u32x4*)(Hin + o_); }
            __builtin_amdgcn_sched_barrier(0);
#pragma unroll
            for (int mm = 0; mm < 2; ++mm) { const int m = 2 * mp + mm; const int row = row0 + ai * HALF + m * 16; const size_t ro = (size_t)row * D; const float rs = rs8[4 * ai + m]; float sq = 0.f;
#pragma unroll
                for (int bj = 0; bj < 2; ++bj) { const int col0 = u.pn * BM + bj * HALF + wc * 32 + 8 * fq;
                    const u32x4 p4 = pw[mm][bj], h4 = hv[mm][bj];
                    const f32x4 g0 = acc[ai][bj][m][0] * rs, g1 = acc[ai][bj][m][1] * rs;
                    float sg[8];
#pragma unroll
                    for (int i = 0; i < 4; ++i) { sg[i] = __builtin_amdgcn_rcpf(1.f + __builtin_amdgcn_exp2f(-g0[i] * LOG2E)); sg[4 + i] = __builtin_amdgcn_rcpf(1.f + __builtin_amdgcn_exp2f(-g1[i] * LOG2E)); }
                    u32x4 w; w.x = pk_bf16(bf_lo(h4.x) + sg[0] * bf_lo(p4.x), bf_hi(h4.x) + sg[1] * bf_hi(p4.x)); w.y = pk_bf16(bf_lo(h4.y) + sg[2] * bf_lo(p4.y), bf_hi(h4.y) + sg[3] * bf_hi(p4.y));
                    w.z = pk_bf16(bf_lo(h4.z) + sg[4] * bf_lo(p4.z), bf_hi(h4.z) + sg[5] * bf_hi(p4.z)); w.w = pk_bf16(bf_lo(h4.w) + sg[6] * bf_lo(p4.w), bf_hi(h4.w) + sg[7] * bf_hi(p4.w));
                    *(u32x4*)(Hout + ro + col0) = w; sq += sq8(w); }
                sq += __shfl_xor(sq, 16); sq += __shfl_xor(sq, 32);
                if (fq == 0) SSo[(size_t)row * 16 + u.pn * 4 + wc] = sq; } }
    }
};
}

#define XB_TMO      128
#define XB_XCNT(j)  (256  + 64 * (j))
#define XB_XSUB(j)  (1280 + 64 * (j))
#define XB_XGEN(j)  (2304 + 64 * (j))
#define XB_TOP      3328
#define XB_TOPGEN   3392
#define XCD_BAR_WORDS 3456
#define XB_SPIN_CAP (1u << 23)
__device__ __forceinline__ unsigned xb_ld(unsigned* p)              { return __hip_atomic_load(p, __ATOMIC_RELAXED, __HIP_MEMORY_SCOPE_AGENT); }
__device__ __forceinline__ unsigned xb_add(unsigned* p, unsigned v) { return __hip_atomic_fetch_add(p, v, __ATOMIC_RELAXED, __HIP_MEMORY_SCOPE_AGENT); }
__device__ __forceinline__ unsigned xb_xcc_id() { return (unsigned)__builtin_amdgcn_s_getreg((3 << 11) | 20) & 0xFu; }
#define XB_SPIN(cond, bar) do { unsigned _sp = 0; while (cond) { __builtin_amdgcn_s_sleep(1); \
    if ((++_sp & 255u) == 0u) { if (xb_ld(&(bar)[XB_TMO])) break; if (_sp > XB_SPIN_CAP) { atomicAdd(&(bar)[XB_TMO], 1u); break; } } } } while (0)
struct XcdBarrier { unsigned* bar; unsigned x; volatile LAS unsigned* st; };
__device__ __forceinline__ XcdBarrier xcd_barrier_post(unsigned* bar, volatile LAS unsigned* st) {
    XcdBarrier b; b.bar = bar; b.x = xb_xcc_id(); b.st = st;
    if (threadIdx.x == 0) (void)xb_add(&bar[XB_XCNT(b.x)], 1u);
    return b;
}
__device__ __forceinline__ void xcd_barrier_complete(unsigned* bar, unsigned x, unsigned& nloc, unsigned& nx) {
    const unsigned G = gridDim.x * gridDim.y * gridDim.z;
    unsigned sum, cnt, mine, sp = 0u;
    for (;;) {
        sum = 0u; cnt = 0u; mine = 0u;
#pragma unroll
        for (unsigned j = 0; j < 16; ++j) { const unsigned c = xb_ld(&bar[XB_XCNT(j)]); sum += c; cnt += (c > 0u) ? 1u : 0u; mine = (j == x) ? c : mine; }
        if (sum == G) break;
        __builtin_amdgcn_s_sleep(1);
        if ((++sp & 255u) == 0u) { if (xb_ld(&bar[XB_TMO])) break; if (sp > XB_SPIN_CAP) { atomicAdd(&bar[XB_TMO], 1u); break; } }
    }
    nloc = mine > 0u ? mine : 1u; nx = cnt > 0u ? cnt : 1u;
}
__device__ __forceinline__ void xcd_barrier(const XcdBarrier& b) {
    asm volatile("s_waitcnt vmcnt(0)" ::: "memory");
    __syncthreads();
    if (threadIdx.x == 0) {
        unsigned* bar = b.bar; unsigned bx_ = b.x;
        asm volatile("" : "+s"(bar), "+s"(bx_));
        __builtin_amdgcn_s_waitcnt(0);
        unsigned nloc = b.st[0], nx = b.st[1];
        if (nloc == 0u) { xcd_barrier_complete(bar, bx_, nloc, nx); b.st[0] = nloc; b.st[1] = nx; }
        const unsigned old = xb_add(&bar[XB_XSUB(bx_)], 1u);
        const unsigned gen = old / nloc;
        if (old + 1u == (gen + 1u) * nloc) {
            __builtin_amdgcn_fence(__ATOMIC_RELEASE, "agent");
            asm volatile("s_waitcnt vmcnt(0)" ::: "memory");
            const unsigned og = xb_add(&bar[XB_TOP], 1u);
            const unsigned tg = og / nx;
            if (og + 1u == (tg + 1u) * nx) xb_add(&bar[XB_TOPGEN], 1u);
            else XB_SPIN(xb_ld(&bar[XB_TOPGEN]) == tg, bar);
            __builtin_amdgcn_fence(__ATOMIC_ACQUIRE, "agent");
            xb_add(&bar[XB_XGEN(bx_)], 1u);
            asm volatile("s_waitcnt vmcnt(0)" ::: "memory");
        } else {
            XB_SPIN(xb_ld(&bar[XB_XGEN(bx_)]) == gen, bar);
            __builtin_amdgcn_fence(__ATOMIC_ACQUIRE, "agent");
            asm volatile("s_waitcnt vmcnt(0)" ::: "memory");
        }
    }
    __syncthreads();
}

struct MapIn { const float* W;
    __device__ __forceinline__ void operator()(int n, const float*& src, int& ld, float& sc) const {
        ld = DIN; sc = 1.f; int o = -1;
        if (n < 640) o = n;
        else if (n < 672) { const int w = n - 640; o = 640 + (w >> 1) + 16 * (w & 1); }
        else if (n < 680) { o = 1696 + (n - 672); sc = 0.044194173824159216f; }
        else if (n < 704) o = -1;
        else if (n < 1024) { o = 672 + (n - 704); sc = LOG2E * 0.125f; }
        else if (n < 1088) o = 992 + (n - 1024);
        else if (n < 1152) o = 1056 + (n - 1088);
        else if (n < 1664) o = 1120 + (n - 1152);
        else if (n < 1728) o = 1632 + (n - 1664);
        else if (n < 2048) { o = 1704 + (n - 1728); sc = LOG2E * 0.125f; }
        else if (n < 2368) o = 2024 + (n - 2048);
        else if (n < 2688) o = 2344 + (n - 2368);
        src = o >= 0 ? W + o : nullptr; } };
struct MapUq { const float* W;
    __device__ __forceinline__ void operator()(int n, const float*& src, int& ld, float& sc) const {
        ld = 576; sc = 0.10206207261596575f * LOG2E;
        if (n >= 576) { src = nullptr; return; }
        const int hh = n / 96, w = n % 96; const int o = hh * 96 + (w < 64 ? w : 64 + ((w - 64) >> 1) + 16 * ((w - 64) & 1)); src = W + o; } };
struct MapUkv { const float* W;
    __device__ __forceinline__ void operator()(int n, const float*& src, int& ld, float& sc) const {
        ld = 768; sc = 1.f; int o; if (n < 384) { o = (n >> 6) * 128 + (n & 63); } else { const int n2 = n - 384; o = (n2 >> 6) * 128 + 64 + (n2 & 63); } src = W + o; } };
struct MapId { const float* W; int ldw;
    __device__ __forceinline__ void operator()(int n, const float*& src, int& ld, float& sc) const { ld = ldw; sc = 1.f; src = W + n; } };
struct MapGu { const float* Wg; const float* Wu;
    __device__ __forceinline__ void operator()(int n, const float*& src, int& ld, float& sc) const {
        ld = DFF; sc = 1.f; const int tile = n >> 8, x = n & 255; src = (x < 128) ? Wg + tile * 128 + x : Wu + tile * 128 + (x - 128); } };

template <class Map>
__device__ __forceinline__ void conv_item(const Map& mp, int K, bf16_t* WT, LAS float* scr, int item, int nblk, const float* gain = nullptr) {
    const int lane = opaque_tid() & 63;
    const int kb = item / nblk, nb = item % nblk, k0 = 64 * kb, n0 = 32 * nb;
    const float* src; int ld; float sc; mp(n0 + (lane & 31), src, ld, sc);
    const float gl = gain ? gain[k0 + lane] : 1.f;
    float v[32];
#pragma unroll
    for (int i = 0; i < 32; ++i) v[i] = 0.f;
    if (src) { const float* sp = src + (size_t)(k0 + (lane >> 5)) * ld;
#pragma unroll
        for (int i = 0; i < 32; ++i) v[i] = sp[(size_t)(2 * i) * ld]; }
#pragma unroll
    for (int i = 0; i < 32; ++i) { const int kk = 2 * i + (lane >> 5); scr[kk * 33 + (lane & 31)] = v[i] * sc * __shfl(gl, kk); }
    asm volatile("s_waitcnt lgkmcnt(0)" ::: "memory");
    const int c = lane & 7;
#pragma unroll
    for (int j = 0; j < 4; ++j) { const int n = (lane >> 3) + 8 * j; const LAS float* s = scr + (8 * c) * 33 + n;
        u32x4 o; o.x = pk_bf16(s[0 * 33], s[1 * 33]); o.y = pk_bf16(s[2 * 33], s[3 * 33]); o.z = pk_bf16(s[4 * 33], s[5 * 33]); o.w = pk_bf16(s[6 * 33], s[7 * 33]);
        *(u32x4*)(WT + (size_t)(n0 + n) * K + k0 + 8 * c) = o; }
    asm volatile("s_waitcnt lgkmcnt(0)" ::: "memory");
}

__device__ __forceinline__ void x_to_h_rows(const float* X, bf16_t* H, float* SSo, int gw, int ngw) {
    const int lane = opaque_tid() & 63;
    for (int m0 = gw; m0 < M; m0 += 4 * ngw) {
        f32x4 v[4][4];
#pragma unroll
        for (int r = 0; r < 4; ++r) { const int m = min(m0 + r * ngw, M - 1);
#pragma unroll
            for (int j = 0; j < 4; ++j) v[r][j] = ((const f32x4*)(X + (size_t)m * D) + lane)[64 * j]; }
        __builtin_amdgcn_sched_barrier(0);
#pragma unroll
        for (int r = 0; r < 4; ++r) { const int m = m0 + r * ngw; if (m < M) {
            u32x2* o8 = (u32x2*)(H + (size_t)m * D) + lane; float sq = 0.f;
#pragma unroll
            for (int j = 0; j < 4; ++j) { u32x2 w; w.x = pk_bf16(v[r][j][0], v[r][j][1]); w.y = pk_bf16(v[r][j][2], v[r][j][3]); o8[64 * j] = w;
                sq += (bf_lo(w.x) * bf_lo(w.x) + bf_hi(w.x) * bf_hi(w.x)) + (bf_lo(w.y) * bf_lo(w.y) + bf_hi(w.y) * bf_hi(w.y)); }
            sq = wave_sum(sq);
            if (lane < 16) SSo[(size_t)m * 16 + lane] = (lane == 0) ? sq : 0.f; } }
    }
}
__device__ __forceinline__ void final_norm_rows(const bf16_t* H, const float* gain, float* Out, int gw, int ngw) {
    const int lane = opaque_tid() & 63;
    f32x4 g[4];
#pragma unroll
    for (int j = 0; j < 4; ++j) g[j] = *(const f32x4*)(gain + 256 * j + 4 * lane);
    for (int m0 = gw; m0 < M; m0 += 4 * ngw) {
        u32x2 hw[4][4];
#pragma unroll
        for (int r = 0; r < 4; ++r) { const int m = min(m0 + r * ngw, M - 1);
#pragma unroll
            for (int j = 0; j < 4; ++j) hw[r][j] = ((const u32x2*)(H + (size_t)m * D) + lane)[64 * j]; }
        __builtin_amdgcn_sched_barrier(0);
#pragma unroll
        for (int r = 0; r < 4; ++r) { const int m = m0 + r * ngw; if (m < M) {
            f32x4 v[4]; float sq = 0.f;
#pragma unroll
            for (int j = 0; j < 4; ++j) { const u32x2 w = hw[r][j]; v[j] = (f32x4){bf_lo(w.x), bf_hi(w.x), bf_lo(w.y), bf_hi(w.y)}; sq += (v[j][0] * v[j][0] + v[j][1] * v[j][1]) + (v[j][2] * v[j][2] + v[j][3] * v[j][3]); }
            const float rr = rsqrtf(wave_sum(sq) * (1.f / D) + EPS);
            f32x4* orow = (f32x4*)(Out + (size_t)m * D) + lane;
#pragma unroll
            for (int j = 0; j < 4; ++j) orow[64 * j] = v[j] * rr * g[j]; } }
    }
}
__device__ __forceinline__ void cvt_p_rows(const float* Pin, bf16_t* PB, int gbase, int nthreads) {
    const int gtid = gbase + opaque_tid();
    const size_t n8 = (size_t)M * PLE / 8;
    for (size_t i0 = gtid; i0 < n8; i0 += (size_t)4 * nthreads) {
        f32x4 a[4], b[4];
#pragma unroll
        for (int r = 0; r < 4; ++r) { const size_t i = (i0 + (size_t)r * nthreads < n8) ? i0 + (size_t)r * nthreads : i0; a[r] = *(const f32x4*)(Pin + i * 8); b[r] = *(const f32x4*)(Pin + i * 8 + 4); }
        __builtin_amdgcn_sched_barrier(0);
#pragma unroll
        for (int r = 0; r < 4; ++r) { const size_t i = i0 + (size_t)r * nthreads; if (i < n8) {
            u32x4 w; w.x = pk_bf16(a[r][0], a[r][1]); w.y = pk_bf16(a[r][2], a[r][3]); w.z = pk_bf16(b[r][0], b[r][1]); w.w = pk_bf16(b[r][2], b[r][3]); *(u32x4*)(PB + i * 8) = w; } }
    }
}
constexpr int MLA_KS = 208, MLA_VS = 144, MLA_KB = 64 * MLA_KS, MLA_VB = 64 * MLA_VS;
#define MLA_BAR() asm volatile("s_waitcnt lgkmcnt(0)\n\ts_barrier" ::: "memory")
#define MLA_KREADS_R(a, b) _Pragma("unroll") for (int ks = (a); ks < (b); ++ks) { kfr[ks][0] = *(LAS const bf16x8*)(kl + ks * 32); kfr[ks][1] = *(LAS const bf16x8*)(kl + 32 * MLA_KS + ks * 32); }
#define MLA_VREADS_R(a, b) _Pragma("unroll") for (int kk = (a); kk < (b); ++kk) { vt[kk][0] = ldtr(vl + (16 * kk) * MLA_VS); vt[kk][1] = ldtr(vl + (16 * kk + 8) * MLA_VS); vt[kk][2] = ldtr(vl + (16 * kk) * MLA_VS + 64); vt[kk][3] = ldtr(vl + (16 * kk + 8) * MLA_VS + 64); }
#define MLA_PV() do { _Pragma("unroll") for (int kk = 0; kk < 4; ++kk) { o0 = mfma32(cat8(vt[kk][0], vt[kk][1]), pb[kk], o0); o1 = mfma32(cat8(vt[kk][2], vt[kk][3]), pb[kk], o1); } } while (0)
__device__ __forceinline__ void mla_qk(LAS const unsigned char* kl, const bf16x8 (&qf)[6], const f32x16& negm, f32x16& s0, f32x16& s1) {
    bf16x8 kfr[6][2];
    MLA_KREADS_R(0, 6);
    __builtin_amdgcn_sched_barrier(0);
    s0 = mfma32(kfr[0][0], qf[0], negm); s1 = mfma32(kfr[0][1], qf[0], negm);
#pragma unroll
    for (int ks = 1; ks < 6; ++ks) { s0 = mfma32(kfr[ks][0], qf[ks], s0); s1 = mfma32(kfr[ks][1], qf[ks], s1); }
}
__device__ __forceinline__ void mla_pv(LAS const unsigned char* vl, const bf16x8 (&pb)[4], f32x16& o0, f32x16& o1) {
    s16x4 vt[4][4];
    MLA_VREADS_R(0, 4);
    __builtin_amdgcn_sched_barrier(0);
    MLA_PV();
}
__device__ __forceinline__ void mla_mfull(LAS const unsigned char* kl, LAS const unsigned char* vl, const bf16x8 (&qf)[6], const f32x16& negm, f32x16& s0, f32x16& s1, const bf16x8 (&pb)[4], f32x16& o0, f32x16& o1) {
    bf16x8 kfr[6][2]; s16x4 vt[4][4];
    MLA_KREADS_R(0, 4); MLA_VREADS_R(0, 1);
    __builtin_amdgcn_sched_barrier(0);
    __builtin_amdgcn_s_setprio(1);
    s0 = mfma32(kfr[0][0], qf[0], negm); s1 = mfma32(kfr[0][1], qf[0], negm); s0 = mfma32(kfr[1][0], qf[1], s0); s1 = mfma32(kfr[1][1], qf[1], s1);
    __builtin_amdgcn_sched_barrier(0);
    MLA_KREADS_R(4, 6);
    __builtin_amdgcn_sched_barrier(0);
    s0 = mfma32(kfr[2][0], qf[2], s0); s1 = mfma32(kfr[2][1], qf[2], s1); s0 = mfma32(kfr[3][0], qf[3], s0); s1 = mfma32(kfr[3][1], qf[3], s1);
    __builtin_amdgcn_sched_barrier(0);
    MLA_VREADS_R(1, 4);
    __builtin_amdgcn_sched_barrier(0);
    s0 = mfma32(kfr[4][0], qf[4], s0); s1 = mfma32(kfr[4][1], qf[4], s1); s0 = mfma32(kfr[5][0], qf[5], s0); s1 = mfma32(kfr[5][1], qf[5], s1);
    __builtin_amdgcn_sched_barrier(0);
    MLA_PV();
    __builtin_amdgcn_s_setprio(0);
}
__device__ __forceinline__ void mla_vseg(f32x16& s0, f32x16& s1, f32x16& o0, f32x16& o1, f32x16& negm, bf16x8 (&pb)[4], float& mref, float& lsum, int j, int ntw, int tq, int hi) {
    if (j >= ntw - 1) {
#pragma unroll
        for (int r = 0; r < 16; ++r) { const int key = j * 64 + crow(r, hi); if (key > tq) s0[r] = -1e30f; if (key + 32 > tq) s1[r] = -1e30f; }
    }
    float mx = fmaxf(s0[0], s1[0]);
#pragma unroll
    for (int r = 1; r < 16; ++r) mx = fmaxf(fmaxf(mx, s0[r]), s1[r]);
    { const auto rr = __builtin_amdgcn_permlane32_swap(__float_as_uint(mx), __float_as_uint(mx), false, false); mx = fmaxf(__uint_as_float(rr[0]), __uint_as_float(rr[1])); }
    if (j == 0 || __any(mx > 8.f)) {
        const float dl = (j == 0) ? mx : fmaxf(mx, 0.f), alpha = __builtin_amdgcn_exp2f(-dl);
        mref += dl; lsum *= alpha; const float nm = -mref;
#pragma unroll
        for (int r = 0; r < 16; ++r) { float a = s0[r], c = s1[r], e = o0[r], f = o1[r], g = negm[r];
            asm volatile("v_sub_f32 %0, %0, %5\n\tv_sub_f32 %1, %1, %5\n\tv_mul_f32 %2, %2, %6\n\tv_mul_f32 %3, %3, %6\n\tv_mov_b32 %4, %7" : "+v"(a), "+v"(c), "+v"(e), "+v"(f), "+v"(g) : "v"(dl), "v"(alpha), "v"(nm));
            s0[r] = a; s1[r] = c; o0[r] = e; o1[r] = f; negm[r] = g; }
    }
    float psA = 0.f, psB = 0.f;
#pragma unroll
    for (int r = 0; r < 16; ++r) { float a = __builtin_amdgcn_exp2f(s0[r]), c = __builtin_amdgcn_exp2f(s1[r]); asm volatile("" : "+v"(a), "+v"(c)); s0[r] = a; s1[r] = c;
        psA += a; psB += c; asm volatile("" : "+v"(psA), "+v"(psB)); }
    lsum += psA + psB;
    pb[0] = pack8(s0[0], s0[1], s0[2], s0[3], s0[4], s0[5], s0[6], s0[7]); pb[1] = pack8(s0[8], s0[9], s0[10], s0[11], s0[12], s0[13], s0[14], s0[15]);
    pb[2] = pack8(s1[0], s1[1], s1[2], s1[3], s1[4], s1[5], s1[6], s1[7]); pb[3] = pack8(s1[8], s1[9], s1[10], s1[11], s1[12], s1[13], s1[14], s1[15]);
}
__device__ __forceinline__ void mla_unit(LAS unsigned char* L, const bf16_t* QM, const bf16_t* KV, const bf16_t* KR, bf16_t* MIX, int b, int h, int qt) {
    const int tid = opaque_tid(), lane = tid & 63, wid = __builtin_amdgcn_readfirstlane(tid >> 6), r32 = lane & 31, hi = lane >> 5, grp = wid >> 2;
    const size_t rowbase = (size_t)b * SEQ; const int q0 = qt * 256, qw = q0 + wid * 32, tq = qw + r32;
    bf16x8 qf[6];
    { const bf16_t* qp = QM + (rowbase + tq) * QM_LD + h * 96 + hi * 8;
#pragma unroll
      for (int ks = 0; ks < 6; ++ks) qf[ks] = *(const bf16x8*)(qp + 16 * ks); }
    const int NT = (q0 + 256) / 64, ntw = (qw >> 6) + 1;
    const int krow = tid >> 3, kch = tid & 7, rrow = tid >> 2, rch = tid & 3;
    const unsigned char* bK = (const unsigned char*)(KV + rowbase * KV_LD + h * 64);
    const unsigned char* bR = (const unsigned char*)(KR + rowbase * 32);
    const unsigned oK = (unsigned)(krow * KV_LD + kch * 8) * 2u, oR = (unsigned)((rrow & 63) * 32 + rch * 8) * 2u;
    const int lK = krow * MLA_KS + kch * 16, lR = (rrow & 63) * MLA_KS + 128 + rch * 16, lV = 2 * MLA_KB + krow * MLA_VS + kch * 16;
    u32x4 sk, sv, sr;
#define MLA_LOADK(t) do { const size_t go_ = (size_t)(t) * 64; sk = *(const u32x4*)(bK + go_ * (KV_LD * 2) + oK); if (tid < 256) sr = *(const u32x4*)(bR + go_ * 64 + oR); } while (0)
#define MLA_LOADV(t) do { sv = *(const u32x4*)(bK + (size_t)(t) * 64 * (KV_LD * 2) + 768 + oK); } while (0)
#define MLA_WRITEK(t) do { const int ko_ = ((t) & 1) * MLA_KB; *(LAS u32x4*)(L + ko_ + lK) = sk; if (tid < 256) *(LAS u32x4*)(L + ko_ + lR) = sr; } while (0)
#define MLA_WRITEV(t) do { *(LAS u32x4*)(L + ((t) & 1) * MLA_VB + lV) = sv; } while (0)
    sr = (u32x4){0, 0, 0, 0};
    MLA_LOADK(0); MLA_WRITEK(0);
    MLA_BAR();
    f32x16 o0 = {}, o1 = {}, negm = {}, s0 = {}, s1 = {}; float mref = 0.f, lsum = 0.f;
    bf16x8 pb[4] = {};
    const int i16 = lane & 15, g4 = lane >> 4;
    LAS const unsigned char* klb = L + r32 * MLA_KS + hi * 16;
    LAS const unsigned char* vlb = L + 2 * MLA_KB + (4 * hi + (i16 >> 2)) * MLA_VS + (16 * (g4 & 1) + 4 * (i16 & 3)) * 2;
    if (grp != 0) __builtin_amdgcn_s_setprio(1);
    if (grp == 0) {
        MLA_LOADK(1); MLA_LOADV(0);
        mla_qk(klb, qf, negm, s0, s1);
        MLA_BAR();
        for (int j = 0; j < NT - 1; ++j) {
            mla_vseg(s0, s1, o0, o1, negm, pb, mref, lsum, j, ntw, tq, hi);
            MLA_WRITEK(j + 1); MLA_WRITEV(j);
            MLA_BAR();
            MLA_LOADK(min(j + 2, NT - 1)); MLA_LOADV(j + 1);
            mla_mfull(klb + ((j + 1) & 1) * MLA_KB, vlb + (j & 1) * MLA_VB, qf, negm, s0, s1, pb, o0, o1);
            MLA_BAR();
        }
        mla_vseg(s0, s1, o0, o1, negm, pb, mref, lsum, NT - 1, ntw, tq, hi);
        MLA_WRITEV(NT - 1);
        MLA_BAR();
        mla_pv(vlb + ((NT - 1) & 1) * MLA_VB, pb, o0, o1);
        MLA_BAR();
        MLA_BAR();
    } else {
        MLA_LOADK(1); MLA_LOADV(0);
        MLA_BAR();
        mla_qk(klb, qf, negm, s0, s1);
        MLA_WRITEK(1); MLA_WRITEV(0);
        MLA_BAR();
        for (int j = 0; j < NT - 1; ++j) {
            MLA_LOADK(min(j + 2, NT - 1)); MLA_LOADV(j + 1);
            mla_vseg(s0, s1, o0, o1, negm, pb, mref, lsum, j, ntw, tq, hi);
            MLA_BAR();
            mla_mfull(klb + ((j + 1) & 1) * MLA_KB, vlb + (j & 1) * MLA_VB, qf, negm, s0, s1, pb, o0, o1);
            MLA_WRITEK(j + 2); MLA_WRITEV(j + 1);
            MLA_BAR();
        }
        mla_vseg(s0, s1, o0, o1, negm, pb, mref, lsum, NT - 1, ntw, tq, hi);
        MLA_BAR();
        mla_pv(vlb + ((NT - 1) & 1) * MLA_VB, pb, o0, o1);
        MLA_BAR();
    }
    __builtin_amdgcn_s_setprio(0);
    lsum += __shfl_xor(lsum, 32);
    const float inv = 1.f / lsum;
    const int tid2 = opaque_tid();
    bf16_t* orow = MIX + (rowbase + q0 + (tid2 >> 6) * 32 + (tid2 & 31)) * D + h * 64 + 4 * ((tid2 >> 5) & 1);
#pragma unroll
    for (int g = 0; g < 4; ++g) {
        u32x2 w0, w1; w0.x = pk_bf16(o0[4 * g] * inv, o0[4 * g + 1] * inv); w0.y = pk_bf16(o0[4 * g + 2] * inv, o0[4 * g + 3] * inv);
        w1.x = pk_bf16(o1[4 * g] * inv, o1[4 * g + 1] * inv); w1.y = pk_bf16(o1[4 * g + 2] * inv, o1[4 * g + 3] * inv);
        *(u32x2*)(orow + 8 * g) = w0; *(u32x2*)(orow + 32 + 8 * g) = w1;
    }
}

constexpr int SB_VS = 144;
__device__ __forceinline__ void sb_unit(LAS unsigned char* L, const bf16_t* P, bf16_t* MIX, int b, int qt, int h) {
    const int tid = opaque_tid(), lane = tid & 63, wid = __builtin_amdgcn_readfirstlane(tid >> 6), r32 = lane & 31, hi = lane >> 5;
    const size_t rowbase = (size_t)b * SEQ; const int qw = qt * 256 + wid * 32, tq = qw + r32;
    LAS unsigned char* vl = L + wid * (32 * SB_VS);
    bf16x8 qf[4];
    { const bf16_t* qp = P + (rowbase + tq) * NP + C_SQ + h * 64 + hi * 8;
#pragma unroll
      for (int ks = 0; ks < 4; ++ks) qf[ks] = *(const bf16x8*)(qp + 16 * ks); }
    f32x16 o0 = {}, o1 = {}; float R = 0.f;
    const int i16 = lane & 15, g4 = lane >> 4;
    const int vtr_off = (4 * hi + (i16 >> 2)) * SB_VS + (16 * (g4 & 1) + 4 * (i16 & 3)) * 2;
    bf16x8 kf[4], kfn[4]; u32x4 vst[4], vstn[4];
#define SB_LOADKV(KF, VS, kbb) do { const int k0_ = (kbb) * 32; const bf16_t* kp_ = P + (rowbase + k0_ + r32) * NP + C_SK + h * 64 + hi * 8; \
        _Pragma("unroll") for (int ks = 0; ks < 4; ++ks) KF[ks] = *(const bf16x8*)(kp_ + 16 * ks); \
        _Pragma("unroll") for (int i = 0; i < 4; ++i) VS[i] = *(const u32x4*)(P + (rowbase + k0_ + 8 * i + (lane >> 3)) * NP + C_SV + h * 64 + (lane & 7) * 8); } while (0)
    SB_LOADKV(kf, vst, qw >> 5);
    for (int kb = qw >> 5; kb >= 0; --kb) {
        const int k0 = kb * 32;
        SB_LOADKV(kfn, vstn, max(kb - 1, 0));
        __builtin_amdgcn_sched_barrier(0);
#pragma unroll
        for (int i = 0; i < 4; ++i) *(LAS u32x4*)(vl + (8 * i + (lane >> 3)) * SB_VS + (lane & 7) * 16) = vst[i];
        f32x16 z = {};
#pragma unroll
        for (int ks = 0; ks < 4; ++ks) z = mfma32(kf[ks], qf[ks], z);
        float lb[16], l1[16];
        const bool diag = (k0 == qw);
#pragma unroll
        for (int r = 0; r < 16; ++r) { const float zz = z[r]; const float e = __builtin_amdgcn_exp2f(-fabsf(zz)); const float Lg = __builtin_amdgcn_logf(1.f + e);
            lb[r] = fminf(zz, 0.f) - Lg; l1[r] = lb[r] - zz;
            if (diag && crow(r, hi) >= r32) { lb[r] = -1e30f; l1[r] = 0.f; } }
        float G[4], PG[4], T[4];
#pragma unroll
        for (int g = 0; g < 4; ++g) { G[g] = (l1[4 * g] + l1[4 * g + 1]) + (l1[4 * g + 2] + l1[4 * g + 3]); PG[g] = __shfl_xor(G[g], 32); T[g] = G[g] + PG[g]; }
        float tail[4]; tail[3] = 0.f; tail[2] = T[3]; tail[1] = T[3] + T[2]; tail[0] = tail[1] + T[1];
        float w[16];
#pragma unroll
        for (int g = 0; g < 4; ++g) { float s = R + tail[g] + (hi == 0 ? PG[g] : 0.f);
            w[4 * g + 3] = __builtin_amdgcn_exp2f(lb[4 * g + 3] + s); s += l1[4 * g + 3];
            w[4 * g + 2] = __builtin_amdgcn_exp2f(lb[4 * g + 2] + s); s += l1[4 * g + 2];
            w[4 * g + 1] = __builtin_amdgcn_exp2f(lb[4 * g + 1] + s); s += l1[4 * g + 1];
            w[4 * g + 0] = __builtin_amdgcn_exp2f(lb[4 * g + 0] + s); }
        R += tail[0] + T[0];
        const bf16x8 pb0 = pack8(w[0], w[1], w[2], w[3], w[4], w[5], w[6], w[7]), pb1 = pack8(w[8], w[9], w[10], w[11], w[12], w[13], w[14], w[15]);
        asm volatile("s_waitcnt lgkmcnt(0)" ::: "memory");
        LAS const unsigned char* vp = vl + vtr_off;
        { const bf16x8 va = cat8(ldtr(vp), ldtr(vp + 8 * SB_VS)), vb = cat8(ldtr(vp + 64), ldtr(vp + 8 * SB_VS + 64)); o0 = mfma32(va, pb0, o0); o1 = mfma32(vb, pb0, o1); }
        { const bf16x8 va = cat8(ldtr(vp + 16 * SB_VS), ldtr(vp + 24 * SB_VS)), vb = cat8(ldtr(vp + 16 * SB_VS + 64), ldtr(vp + 24 * SB_VS + 64)); o0 = mfma32(va, pb1, o0); o1 = mfma32(vb, pb1, o1); }
        asm volatile("s_waitcnt lgkmcnt(0)" ::: "memory");
        if (__all(R < -160.f)) break;
#pragma unroll
        for (int i = 0; i < 4; ++i) { kf[i] = kfn[i]; vst[i] = vstn[i]; }
    }
#undef SB_LOADKV
    bf16_t* orow = MIX + (rowbase + tq) * D + 704 + h * 64 + 4 * hi;
#pragma unroll
    for (int g = 0; g < 4; ++g) {
        u32x2 w0, w1; w0.x = pk_bf16(o0[4 * g], o0[4 * g + 1]); w0.y = pk_bf16(o0[4 * g + 2], o0[4 * g + 3]);
        w1.x = pk_bf16(o1[4 * g], o1[4 * g + 1]); w1.y = pk_bf16(o1[4 * g + 2], o1[4 * g + 3]);
        *(u32x2*)(orow + 8 * g) = w0; *(u32x2*)(orow + 32 + 8 * g) = w1;
    }
}

constexpr int DSA_CAP = 256;
constexpr int DSL_CAP = 512, DSL_KS = 100;
struct DsaPrm { LAS int* b0; LAS int* b1; LAS int* krem; LAS int* cin; LAS unsigned* nsel; LAS unsigned* ncand; LAS float* sc0; LAS float* off0; LAS float* sc1; LAS float* off1; LAS int* part; LAS int* flag; };
__device__ __forceinline__ DsaPrm dsa_prm(LAS unsigned char* L) {
    DsaPrm p; LAS int* w = (LAS int*)(L + L_PRM);
    p.b0 = w; p.b1 = w + 32; p.krem = w + 64; p.cin = w + 96; p.nsel = (LAS unsigned*)(w + 128); p.ncand = (LAS unsigned*)(w + 160);
    p.sc0 = (LAS float*)(w + 192); p.off0 = (LAS float*)(w + 224); p.sc1 = (LAS float*)(w + 256); p.off1 = (LAS float*)(w + 288); p.part = w + 320; p.flag = w + 832; return p;
}
struct DsaLane { float sc0, off0, sc1, off1; int b0, b1; };
template <int MODE, bool DIAG>
__device__ __forceinline__ void dsa_classify(LAS unsigned char* L, const float (&x)[16], const DsaLane& dl, int kb, int tq, int qloc, int wid, int lane) {
    const int g4 = lane >> 4;
    int key0 = kb + 4 * g4;
    if (DIAG) asm volatile("" : "+v"(key0));
    LAS unsigned* hist = (LAS unsigned*)(L + L_H) + qloc * 1024;
    if (MODE == 3) {
        const float b0f = (dl.b0 == 0) ? -3.0e38f : (float)dl.b0;
        unsigned mge = 0u;
#pragma unroll
        for (int i = 0; i < 16; ++i) {
            const bool valid = !DIAG || (key0 + 16 * (i >> 2) + (i & 3) <= tq);
            unsigned gb = (valid && __builtin_fmaf(x[i], dl.sc0, dl.off0) >= b0f) ? 1u : 0u; asm volatile("" : "+v"(gb));
            mge |= gb << i;
        }
        if (mge) {
            LAS float* xs = (LAS float*)(L + L_H + 98304 + wid * 4096);
#pragma unroll
            for (int i = 0; i < 16; ++i) xs[i * 64 + lane] = x[i];
            const DsaPrm pr = dsa_prm(L);
            LAS float* ls = (LAS float*)(L + L_H) + qloc * DSL_CAP; LAS unsigned short* lk = (LAS unsigned short*)(L + L_H + 65536) + qloc * DSL_CAP;
#pragma unroll 1
            while (mge) { const int i = __builtin_ctz(mge); mge &= mge - 1u;
                const float xv = xs[i * 64 + lane];
                const unsigned slot = __hip_atomic_fetch_add(pr.ncand + qloc, 1u, __ATOMIC_RELAXED, __HIP_MEMORY_SCOPE_WORKGROUP);
                if (slot < (unsigned)DSL_CAP) { ls[slot] = xv; lk[slot] = (unsigned short)(kb + 16 * (i >> 2) + 4 * g4 + (i & 3)); } }
        }
    } else if (MODE != 2) {
#pragma unroll
        for (int i = 0; i < 16; ++i) {
            const float xv = x[i];
            const bool valid = !DIAG || (key0 + 16 * (i >> 2) + (i & 3) <= tq);
            int bin = (int)__builtin_fmaf(xv, dl.sc0, dl.off0); bin = min(max(bin, 0), 1023);
            if (MODE == 0) { if (valid) __hip_atomic_fetch_add(hist + bin, 1u, __ATOMIC_RELAXED, __HIP_MEMORY_SCOPE_WORKGROUP); }
            else { int c1 = (int)__builtin_fmaf(xv, dl.sc1, dl.off1); c1 = min(max(c1, 0), 1023);
                if (valid && bin == dl.b0) __hip_atomic_fetch_add(hist + c1, 1u, __ATOMIC_RELAXED, __HIP_MEMORY_SCOPE_WORKGROUP); }
        }
    } else {
        const float b0f = (dl.b0 == 0) ? -3.0e38f : (float)dl.b0;
        unsigned mge = 0u;
#pragma unroll
        for (int i = 0; i < 16; ++i) {
            const bool valid = !DIAG || (key0 + 16 * (i >> 2) + (i & 3) <= tq);
            unsigned gb = (valid && __builtin_fmaf(x[i], dl.sc0, dl.off0) >= b0f) ? 1u : 0u; asm volatile("" : "+v"(gb));
            mge |= gb << i;
        }
        if (mge) {
            LAS float* xs = (LAS float*)(L + L_H + 65536 + wid * 4096);
#pragma unroll
            for (int i = 0; i < 16; ++i) xs[i * 64 + lane] = x[i];
            const DsaPrm pr = dsa_prm(L);
            LAS float* cand_s = (LAS float*)(L + L_H) + qloc * DSA_CAP; LAS unsigned* cand_k = (LAS unsigned*)(L + L_H + 32768) + qloc * DSA_CAP;
            unsigned w0 = 0u, w1 = 0u;
#pragma unroll 1
            while (mge) { const int i = __builtin_ctz(mge); mge &= mge - 1u;
                const float xv = xs[i * 64 + lane];
                int bin = (int)__builtin_fmaf(xv, dl.sc0, dl.off0); bin = min(max(bin, 0), 1023);
                int c1 = (int)__builtin_fmaf(xv, dl.sc1, dl.off1); c1 = min(max(c1, 0), 1023);
                const int koff = 16 * (i >> 2) + 4 * g4 + (i & 3);
                if (bin > dl.b0 || (bin == dl.b0 && c1 > dl.b1)) { if (koff < 32) w0 |= 1u << koff; else w1 |= 1u << (koff - 32); }
                else if (bin == dl.b0 && c1 == dl.b1) { const unsigned cb = __hip_atomic_fetch_add(pr.ncand + qloc, 1u, __ATOMIC_RELAXED, __HIP_MEMORY_SCOPE_WORKGROUP);
                    if (cb < (unsigned)DSA_CAP) { cand_s[cb] = xv; cand_k[cb] = (unsigned)(kb + koff); } }
            }
            LAS unsigned* bm = (LAS unsigned*)(L + L_H + 98304) + qloc * 256 + (kb >> 5);
            if (w0) __hip_atomic_fetch_or(bm, w0, __ATOMIC_RELAXED, __HIP_MEMORY_SCOPE_WORKGROUP);
            if (w1) __hip_atomic_fetch_or(bm + 1, w1, __ATOMIC_RELAXED, __HIP_MEMORY_SCOPE_WORKGROUP);
        }
    }
}
#define DSA_MM(dst, st) do { constexpr int h0_ = ((st) & 1) ? 4 : 0, nh_ = ((st) & 1) ? 5 : 4; \
        _Pragma("unroll") for (int h_ = 0; h_ < nh_; ++h_) dst[h_] = mfma16(kf[(st) >> 1][0], qf[h0_ + h_][0], (f32x4){0.f, 0.f, 0.f, 0.f}); \
        _Pragma("unroll") for (int h_ = 0; h_ < nh_; ++h_) dst[h_] = mfma16(kf[(st) >> 1][1], qf[h0_ + h_][1], dst[h_]); } while (0)
__device__ __forceinline__ float add_asm(float y, float t) { asm volatile("v_add_f32 %0, %1, %0" : "+v"(t) : "v"(y)); return t; }
__device__ __forceinline__ float fma_abs(float y, float sgn, float t) { asm volatile("v_fma_f32 %0, |%1|, %2, %0" : "+v"(t) : "v"(y), "v"(sgn)); return t; }
#define DSA_VA(src, st) do { constexpr int h0_ = ((st) & 1) ? 4 : 0; f32x4 t_ = xa[(st) >> 1]; \
        _Pragma("unroll") for (int h_ = 0; h_ < 4; ++h_) { const float s_ = sg[h0_ + h_]; \
            _Pragma("unroll") for (int r_ = 0; r_ < 4; ++r_) t_[r_] = fma_abs(src[h_][r_], s_, t_[r_]); } \
        if ((st) & 1) { _Pragma("unroll") for (int r_ = 0; r_ < 4; ++r_) t_[r_] = add_asm(src[4][r_], t_[r_]); } \
        xa[(st) >> 1] = t_; } while (0)
#define DSA_SGB(n) do { _Pragma("unroll") for (int i_ = 0; i_ < (n); ++i_) { __builtin_amdgcn_sched_group_barrier(0x008, 1, 0); __builtin_amdgcn_sched_group_barrier(0x002, 2, 0); } } while (0)
template <int MODE>
__device__ __forceinline__ void dsa_group(LAS unsigned char* L, const bf16x8 (&kf)[4][2], const bf16x8 (&qf)[9][2], const float (&sg)[8], const DsaLane& dl, int kb, int t0, int tq, int qloc, int wid, int lane) {
    f32x4 xa[4];
#pragma unroll
    for (int b_ = 0; b_ < 4; ++b_) xa[b_] = (f32x4){0.f, 0.f, 0.f, 0.f};
    f32x4 aA[5], aB[5];
#define DSA_SB() __builtin_amdgcn_sched_barrier(0)
    DSA_MM(aA, 0); DSA_SB();
    DSA_MM(aB, 1); DSA_SB(); DSA_VA(aA, 0); DSA_SB();
    DSA_MM(aA, 2); DSA_SB(); DSA_VA(aB, 1); DSA_SB();
    DSA_MM(aB, 3); DSA_SB(); DSA_VA(aA, 2); DSA_SB();
    DSA_MM(aA, 4); DSA_SB(); DSA_VA(aB, 3); DSA_SB();
    DSA_MM(aB, 5); DSA_SB(); DSA_VA(aA, 4); DSA_SB();
    DSA_MM(aA, 6); DSA_SB(); DSA_VA(aB, 5); DSA_SB();
    DSA_MM(aB, 7); DSA_SB(); DSA_VA(aA, 6); DSA_SB();
    asm volatile("s_nop 7\n\ts_nop 7" ::: "memory");
    DSA_VA(aB, 7); DSA_SB();
#undef DSA_SB
    float x[16];
#pragma unroll
    for (int b_ = 0; b_ < 4; ++b_) { x[4 * b_] = xa[b_][0]; x[4 * b_ + 1] = xa[b_][1]; x[4 * b_ + 2] = xa[b_][2]; x[4 * b_ + 3] = xa[b_][3]; }
    __builtin_amdgcn_sched_barrier(0);
    if (kb + 63 > t0) dsa_classify<MODE, true>(L, x, dl, kb, tq, qloc, wid, lane); else dsa_classify<MODE, false>(L, x, dl, kb, tq, qloc, wid, lane);
    __builtin_amdgcn_sched_barrier(0);
}
#define DSA_LOADK(buf, grp) do { const GAS bf16_t* kp_ = Pb + (size_t)(64 * (grp) + i16) * 64 + 8 * g4; \
    _Pragma("unroll") for (int blk_ = 0; blk_ < 4; ++blk_) { buf[blk_][0] = *(const GAS bf16x8*)(kp_ + (size_t)(16 * blk_) * 64); buf[blk_][1] = *(const GAS bf16x8*)(kp_ + (size_t)(16 * blk_) * 64 + 32); } } while (0)
template <int MODE>
__device__ __forceinline__ void dsa_pass(LAS unsigned char* L, const bf16_t* Pb_, const bf16x8 (&qf)[9][2], const float (&wh)[8], int t0_, int wid, int lane_, bool dry = false, int gstep = 4) {
    const GAS bf16_t* Pb = (const GAS bf16_t*)Pb_; int t0 = t0_, lane = lane_;
    asm volatile("" : "+s"(Pb), "+s"(t0), "+v"(lane));
    const int i16 = lane & 15, g4 = lane >> 4, qh = wid >> 2, kslot = wid & 3;
    const int qloc = 16 * qh + i16, tq = t0 + qloc, T = t0 + 32;
    const DsaPrm pr = dsa_prm(L);
    DsaLane dl; dl.sc0 = pr.sc0[qloc]; dl.off0 = pr.off0[qloc]; dl.sc1 = pr.sc1[qloc]; dl.off1 = pr.off1[qloc]; dl.b0 = dry ? -1 : pr.b0[qloc]; dl.b1 = pr.b1[qloc];
    const int ngroups = (T + 63) >> 6, glast = ngroups - 1;
    bf16x8 kf[4][2], kn[4][2];
    int g = kslot;
    DSA_LOADK(kf, min(g, glast));
#pragma unroll 1
    while (g < ngroups) {
        DSA_LOADK(kn, min(g + gstep, glast));
        __builtin_amdgcn_sched_barrier(0);
        dsa_group<MODE>(L, kf, qf, wh, dl, 64 * g, t0, tq, qloc, wid, lane);
        g += gstep;
        if (g >= ngroups) break;
        DSA_LOADK(kf, min(g + gstep, glast));
        __builtin_amdgcn_sched_barrier(0);
        dsa_group<MODE>(L, kn, qf, wh, dl, 64 * g, t0, tq, qloc, wid, lane);
        g += gstep;
    }
}
__device__ __forceinline__ void dsa_binsearch(LAS unsigned char* L, LAS int* bout, int level) {
    const int tid = opaque_tid(), lane = tid & 63, q = tid >> 4, sub = tid & 15;
    const DsaPrm pr = dsa_prm(L);
    LAS const unsigned* hist = (LAS const unsigned*)(L + L_H) + q * 1024;
    int s = 0;
#pragma unroll
    for (int i = 0; i < 16; ++i) { const u32x4 h4 = *(LAS const u32x4*)(hist + 64 * sub + 4 * ((i + lane) & 15)); s += (int)((h4.x + h4.y) + (h4.z + h4.w)); }
    pr.part[q * 16 + sub] = s;
    __syncthreads();
    if (sub == 0) {
        const int k = pr.krem[q]; int acc = 0, c = 0;
        { u32x4 pp[4];
#pragma unroll
          for (int i = 0; i < 4; ++i) pp[i] = *(LAS const u32x4*)(pr.part + q * 16 + 4 * i);
          bool dn = false;
#pragma unroll
          for (int cc = 15; cc >= 1; --cc) { const int p = (int)pp[cc >> 2][cc & 3]; const bool hit = !dn && (acc + p >= k); c = hit ? cc : c; dn = dn || hit; acc += dn ? 0 : p; } }
        int j = 0;
        { u32x4 hb[16];
#pragma unroll
          for (int i = 0; i < 16; ++i) hb[i] = *(LAS const u32x4*)(hist + 64 * c + 4 * i);
          bool dn = false;
#pragma unroll
          for (int jj = 63; jj >= 1; --jj) { const int v = (int)hb[jj >> 2][jj & 3]; const bool hit = !dn && (acc + v >= k); j = hit ? jj : j; dn = dn || hit; acc += dn ? 0 : v; } }
        const int bb = 64 * c + j; const int cin = (int)hist[bb];
        bout[q] = bb; pr.cin[q] = cin; pr.krem[q] = k - acc;
        if (level == 0) {
            const float sc0 = pr.sc0[q], off0 = pr.off0[q];
            const float sc1 = sc0 * 1024.f; pr.sc1[q] = sc1; pr.off1[q] = (off0 - (float)bb) * 1024.f;
            if (cin > DSA_CAP) pr.flag[0] = 1;
        }
    }
    __syncthreads();
}
__device__ __forceinline__ void dsa_zero_hist(LAS unsigned char* L) {
    const int tid = opaque_tid();
    const u32x4 z4 = opaque_splat(0u);
#pragma unroll
    for (int i = 0; i < 16; ++i) *(LAS u32x4*)(L + L_H + (i * 512 + tid) * 16) = z4;
}
constexpr int DSA_VS = 144;
__device__ __forceinline__ void dsa_unit(LAS unsigned char* L, const bf16_t* P, const bf16_t* IKC, const bf16_t* DKV, bf16_t* MIX, const unsigned* kmaxw, int b, int qt) {
    const int tid = opaque_tid(), lane = tid & 63, wid = __builtin_amdgcn_readfirstlane(tid >> 6), r32 = lane & 31, hi = lane >> 5;
    const size_t rowbase = (size_t)b * SEQ; const int t0 = qt * 32;
    const bf16_t* Pb = P + rowbase * NP;
    const bf16_t* IKb = IKC + rowbase * 64; const bf16_t* DKVb = DKV + rowbase * 128;
    const DsaPrm pr = dsa_prm(L);
    LAS unsigned short* selall = (LAS unsigned short*)(L + L_SEL);
    if (qt < 8) {
        for (int i = tid; i < 32 * 256; i += NTHREADS) selall[i] = (unsigned short)(((i & 255) <= t0 + (i >> 8)) ? (i & 255) : 0xFFFF);
        if (tid < 32) pr.nsel[tid] = (unsigned)(t0 + tid + 1);
        __syncthreads();
    } else {
        bf16x8 qf[9][2]; float wh[8];
        const int i16q = lane & 15, g4q = lane >> 4, qh = wid >> 2, qloc = 16 * qh + i16q;
        float Rloc = 0.f;
        float kmx_pre = 0.f;
        { const bf16_t* qp = Pb + (size_t)(t0 + qloc) * NP + C_IQ + 8 * g4q;
          const u32x4 wv = *(const u32x4*)(Pb + (size_t)(t0 + qloc) * NP + C_IW);
          u32x4 qraw[8][2];
#pragma unroll
          for (int h = 0; h < 8; ++h)
#pragma unroll
              for (int ks = 0; ks < 2; ++ks) qraw[h][ks] = *(const u32x4*)(qp + h * 64 + 32 * ks);
          if (tid < 32) kmx_pre = sqrtf(__uint_as_float(kmaxw[64 * b]) + __uint_as_float(kmaxw[64 * b + 1]));
          __builtin_amdgcn_sched_barrier(0);
          if (t0 + 32 >= 2048) {
              dsa_zero_hist(L);
              const u32x4 z4 = opaque_splat(0u); for (int i = tid; i < 16384 / 16; i += NTHREADS) ((LAS u32x4*)(L + L_SEL))[i] = z4; }
          __builtin_amdgcn_sched_barrier(0);
          const float wr[8] = {bf_lo(wv.x), bf_hi(wv.x), bf_lo(wv.y), bf_hi(wv.y), bf_lo(wv.z), bf_hi(wv.z), bf_lo(wv.w), bf_hi(wv.w)};
          float qs[2][8];
#pragma unroll
          for (int ks = 0; ks < 2; ++ks)
#pragma unroll
              for (int j = 0; j < 8; ++j) qs[ks][j] = 0.f;
          float rsum = 0.f;
#pragma unroll
          for (int h = 0; h < 8; ++h) { wh[h] = (wr[h] < 0.f) ? -1.f : 1.f; float ss = 0.f;
#pragma unroll
              for (int ks = 0; ks < 2; ++ks) { const u32x4 u = qraw[h][ks];
                  float v[8] = {bf_lo(u.x), bf_hi(u.x), bf_lo(u.y), bf_hi(u.y), bf_lo(u.z), bf_hi(u.z), bf_lo(u.w), bf_hi(u.w)};
#pragma unroll
                  for (int j = 0; j < 8; ++j) { v[j] *= wr[h]; qs[ks][j] += v[j]; }
                  const bf16x8 pk = pack8(v[0], v[1], v[2], v[3], v[4], v[5], v[6], v[7]); qf[h][ks] = pk;
                  const u32x4 pu = __builtin_bit_cast(u32x4, pk);
                  ss += bf_lo(pu.x) * bf_lo(pu.x) + bf_hi(pu.x) * bf_hi(pu.x) + bf_lo(pu.y) * bf_lo(pu.y) + bf_hi(pu.y) * bf_hi(pu.y) + bf_lo(pu.z) * bf_lo(pu.z) + bf_hi(pu.z) * bf_hi(pu.z) + bf_lo(pu.w) * bf_lo(pu.w) + bf_hi(pu.w) * bf_hi(pu.w); }
              ss += __shfl_xor(ss, 16); ss += __shfl_xor(ss, 32);
              rsum += sqrtf(ss); }
          float ss = 0.f;
#pragma unroll
          for (int ks = 0; ks < 2; ++ks) { const bf16x8 pk = pack8(qs[ks][0], qs[ks][1], qs[ks][2], qs[ks][3], qs[ks][4], qs[ks][5], qs[ks][6], qs[ks][7]); qf[8][ks] = pk;
              const u32x4 pu = __builtin_bit_cast(u32x4, pk);
              ss += bf_lo(pu.x) * bf_lo(pu.x) + bf_hi(pu.x) * bf_hi(pu.x) + bf_lo(pu.y) * bf_lo(pu.y) + bf_hi(pu.y) * bf_hi(pu.y) + bf_lo(pu.z) * bf_lo(pu.z) + bf_hi(pu.z) * bf_hi(pu.z) + bf_lo(pu.w) * bf_lo(pu.w) + bf_hi(pu.w) * bf_hi(pu.w); }
          ss += __shfl_xor(ss, 16); ss += __shfl_xor(ss, 32);
          Rloc = rsum + sqrtf(ss); }
        if ((wid & 3) == 0 && g4q == 0) pr.part[qloc] = __float_as_int(Rloc);
        __syncthreads();
        float Rb = 1.f;
        if (tid < 32) Rb = fmaxf(__int_as_float(pr.part[tid]) * kmx_pre * 1.01f, 1e-30f);
#pragma unroll 1
        for (int rep_sel = 0; rep_sel < REP_DSEL; ++rep_sel) {
        __syncthreads();
        if (tid < 32) {
            pr.sc0[tid] = 512.f / Rb; pr.off0[tid] = 512.f; pr.sc1[tid] = 0.f; pr.off1[tid] = 0.f; pr.b0[tid] = 0; pr.b1[tid] = 0; pr.krem[tid] = 256; pr.nsel[tid] = 0u; pr.ncand[tid] = 0u;
            if (tid == 0) pr.flag[0] = 0;
        }
        bool done_sel = false;
        if (t0 + 32 >= 2048) {
            if (tid < 32) pr.sc0[tid] = 2048.f / Rb;
            __syncthreads();
            dsa_pass<0>(L, IKb, qf, wh, t0, wid, lane, false, 16);
            __syncthreads();
            if (tid < 32) pr.krem[tid] = DSL_KS;
            __syncthreads();
            dsa_binsearch(L, pr.b0, 2);
            if (tid < 32) { pr.ncand[tid] = 0u; pr.krem[tid] = 256; }
            if (tid == 0) pr.flag[0] = 0;
            __syncthreads();
            dsa_pass<3>(L, IKb, qf, wh, t0, wid, lane);
            __syncthreads();
            {
                const int q = tid >> 4, sub = tid & 15;
                LAS unsigned* wh_ = (LAS unsigned*)(L + L_SEL) + q * 128;
                { const int n = min((int)pr.ncand[q], DSL_CAP), bf = pr.b0[q]; const float sc0 = pr.sc0[q], off0 = pr.off0[q];
                  LAS const float* ls = (LAS const float*)(L + L_H) + q * DSL_CAP;
#pragma unroll 1
                  for (int i = sub; i < n; i += 64) {
                      float xs4[4];
#pragma unroll
                      for (int u = 0; u < 4; ++u) xs4[u] = ls[min(i + 16 * u, DSL_CAP - 1)];
#pragma unroll
                      for (int u = 0; u < 4; ++u) if (i + 16 * u < n) { int bin = (int)__builtin_fmaf(xs4[u], sc0, off0); bin = min(max(bin, 0), 1023); __hip_atomic_fetch_add(wh_ + min(bin - bf, 127), 1u, __ATOMIC_RELAXED, __HIP_MEMORY_SCOPE_WORKGROUP); } } }
                __syncthreads();
                int sacc = 0;
#pragma unroll
                for (int i = 0; i < 8; ++i) sacc += (int)wh_[8 * sub + i];
                pr.part[q * 16 + sub] = sacc;
                __syncthreads();
                if (sub == 0) { int acc = 0, c = 0, j = 0;
                    { u32x4 pp[4];
#pragma unroll
                      for (int i = 0; i < 4; ++i) pp[i] = *(LAS const u32x4*)(pr.part + q * 16 + 4 * i);
                      bool dn = false;
#pragma unroll
                      for (int cc = 15; cc >= 1; --cc) { const int p = (int)pp[cc >> 2][cc & 3]; const bool hit = !dn && (acc + p >= 256); c = hit ? cc : c; dn = dn || hit; acc += dn ? 0 : p; } }
                    { u32x4 hb[2];
#pragma unroll
                      for (int i = 0; i < 2; ++i) hb[i] = *(LAS const u32x4*)(wh_ + 8 * c + 4 * i);
                      bool dn = false;
#pragma unroll
                      for (int jj = 7; jj >= 1; --jj) { const int v = (int)hb[jj >> 2][jj & 3]; const bool hit = !dn && (acc + v >= 256); j = hit ? jj : j; dn = dn || hit; acc += dn ? 0 : v; } }
                    const int b0w = 8 * c + j; const int tot = acc + (int)wh_[b0w];
                    pr.b1[q] = b0w; pr.krem[q] = 256 - acc;
                    if (tot < 256 || b0w >= 127 || pr.ncand[q] > (unsigned)DSL_CAP) pr.flag[0] = 1; }
                __syncthreads();
            }
            if (pr.flag[0] == 0) {
                done_sel = true;
                const int q = tid >> 4, sub = tid & 15;
                const int n = (int)pr.ncand[q], bf = pr.b0[q], b0w = pr.b1[q], k = pr.krem[q];
                const float sc0 = pr.sc0[q], off0 = pr.off0[q];
                const float fs = sc0 * 128.f, fo = (off0 - (float)(bf + b0w)) * 128.f;
                LAS const float* ls = (LAS const float*)(L + L_H) + q * DSL_CAP; LAS const unsigned short* lk = (LAS const unsigned short*)(L + L_H + 65536) + q * DSL_CAP;
                LAS unsigned* sh = (LAS unsigned*)(L + L_SEL) + q * 128;
                LAS unsigned* bmq = (LAS unsigned*)(L + L_H + 98304) + q * 256;
                __syncthreads();
                { const u32x4 z4 = opaque_splat(0u); for (int i = tid; i < 32768 / 16; i += NTHREADS) ((LAS u32x4*)(L + L_H + 98304))[i] = z4;
#pragma unroll
                  for (int i = 0; i < 2; ++i) *(LAS u32x4*)(sh + 8 * sub + 4 * i) = z4; }
                if (sub == 0) pr.cin[q] = 0;
                __syncthreads();
#pragma unroll 1
                for (int i = sub; i < n; i += 64) {
                    float xs4[4]; unsigned ks4[4];
#pragma unroll
                    for (int u = 0; u < 4; ++u) { const int ii = min(i + 16 * u, DSL_CAP - 1); xs4[u] = ls[ii]; ks4[u] = lk[ii]; }
#pragma unroll
                    for (int u = 0; u < 4; ++u) if (i + 16 * u < n) { const float xv = xs4[u]; int bin = (int)__builtin_fmaf(xv, sc0, off0); bin = min(max(bin, 0), 1023); const int w = min(bin - bf, 127);
                        if (w > b0w) { const unsigned ki = ks4[u]; __hip_atomic_fetch_or(bmq + (ki >> 5), 1u << (ki & 31u), __ATOMIC_RELAXED, __HIP_MEMORY_SCOPE_WORKGROUP); }
                        else if (w == b0w) { int c = (int)__builtin_fmaf(xv, fs, fo); c = min(max(c, 0), 127); __hip_atomic_fetch_add(sh + c, 1u, __ATOMIC_RELAXED, __HIP_MEMORY_SCOPE_WORKGROUP); } } }
                __syncthreads();
                { int sacc = 0;
#pragma unroll
                  for (int i = 0; i < 8; ++i) sacc += (int)sh[8 * sub + i];
                  pr.part[q * 16 + sub] = sacc; }
                __syncthreads();
                if (sub == 0) { int acc = 0, c = 0, j = 0;
                    { u32x4 pp[4];
#pragma unroll
                      for (int i = 0; i < 4; ++i) pp[i] = *(LAS const u32x4*)(pr.part + q * 16 + 4 * i);
                      bool dn = false;
#pragma unroll
                      for (int cc = 15; cc >= 1; --cc) { const int p = (int)pp[cc >> 2][cc & 3]; const bool hit = !dn && (acc + p >= k); c = hit ? cc : c; dn = dn || hit; acc += dn ? 0 : p; } }
                    { u32x4 hb[2];
#pragma unroll
                      for (int i = 0; i < 2; ++i) hb[i] = *(LAS const u32x4*)(sh + 8 * c + 4 * i);
                      bool dn = false;
#pragma unroll
                      for (int jj = 7; jj >= 1; --jj) { const int v = (int)hb[jj >> 2][jj & 3]; const bool hit = !dn && (acc + v >= k); j = hit ? jj : j; dn = dn || hit; acc += dn ? 0 : v; } }
                    pr.b1[q] = 8 * c + j; pr.krem[q] = k - acc; }
                __syncthreads();
                const int b2 = pr.b1[q], k2 = pr.krem[q];
                LAS unsigned short* tie = (LAS unsigned short*)sh;
                __syncthreads();
#pragma unroll 1
                for (int i = sub; i < n; i += 64) {
                    float xs4[4]; unsigned ks4[4];
#pragma unroll
                    for (int u = 0; u < 4; ++u) { const int ii = min(i + 16 * u, DSL_CAP - 1); xs4[u] = ls[ii]; ks4[u] = lk[ii]; }
#pragma unroll
                    for (int u = 0; u < 4; ++u) if (i + 16 * u < n) { const float xv = xs4[u]; int bin = (int)__builtin_fmaf(xv, sc0, off0); bin = min(max(bin, 0), 1023);
                        if (min(bin - bf, 127) == b0w) { int c = (int)__builtin_fmaf(xv, fs, fo); c = min(max(c, 0), 127);
                            if (c > b2) { const unsigned ki = ks4[u]; __hip_atomic_fetch_or(bmq + (ki >> 5), 1u << (ki & 31u), __ATOMIC_RELAXED, __HIP_MEMORY_SCOPE_WORKGROUP); }
                            else if (c == b2) { const unsigned pos = __hip_atomic_fetch_add((LAS unsigned*)pr.cin + q, 1u, __ATOMIC_RELAXED, __HIP_MEMORY_SCOPE_WORKGROUP); if (pos < 256u) tie[pos] = (unsigned short)(i + 16 * u); } } } }
                __syncthreads();
                const int nt = min(pr.cin[q], 256);
#pragma unroll 1
                for (int a = sub; a < nt; a += 16) { const int ia = tie[a]; const float si = ls[ia]; const unsigned ki = lk[ia]; int rank = 0;
#pragma unroll 1
                    for (int bb = 0; bb < nt; ++bb) { const int ib = tie[bb]; const float sj = ls[ib]; const unsigned kj = lk[ib]; rank += (sj > si || (sj == si && kj < ki)) ? 1 : 0; }
                    if (rank < k2) __hip_atomic_fetch_or(bmq + (ki >> 5), 1u << (ki & 31u), __ATOMIC_RELAXED, __HIP_MEMORY_SCOPE_WORKGROUP); }
                __syncthreads();
            }
        }
        if (!done_sel) {
        __syncthreads();
        if (tid < 32) { pr.sc0[tid] = 512.f / Rb; pr.sc1[tid] = 0.f; pr.off1[tid] = 0.f; pr.b0[tid] = 0; pr.b1[tid] = 0; pr.krem[tid] = 256; pr.ncand[tid] = 0u; }
        if (tid == 0) pr.flag[0] = 0;
        __syncthreads();
        for (int pr_ = 0; pr_ < PROBE_DRY; ++pr_) { __syncthreads(); dsa_pass<1>(L, IKb, qf, wh, t0, wid, lane, true); __syncthreads(); }
        for (int pr_ = 0; pr_ < PROBE_HIST; ++pr_) { __syncthreads(); dsa_pass<0>(L, IKb, qf, wh, t0, wid, lane); __syncthreads(); }
        for (int pr_ = 0; pr_ < PROBE_ZERO; ++pr_) { dsa_zero_hist(L); __syncthreads(); __syncthreads(); }
        dsa_zero_hist(L);
        __syncthreads();
        dsa_pass<0>(L, IKb, qf, wh, t0, wid, lane);
        __syncthreads();
        dsa_binsearch(L, pr.b0, 0);
        const bool lvl1 = pr.flag[0] != 0;
        if (lvl1) {
            dsa_zero_hist(L);
            __syncthreads();
            dsa_pass<1>(L, IKb, qf, wh, t0, wid, lane);
            __syncthreads();
            dsa_binsearch(L, pr.b1, 1);
        } else { if (tid < 32) { pr.sc1[tid] = 0.f; pr.off1[tid] = 0.f; pr.b1[tid] = 0; } }
        { const u32x4 z4 = opaque_splat(0u); for (int i = tid; i < 32768 / 16; i += NTHREADS) ((LAS u32x4*)(L + L_H + 98304))[i] = z4; }
        __syncthreads();
        dsa_pass<2>(L, IKb, qf, wh, t0, wid, lane);
        __syncthreads();
        {
            const int q = tid >> 4, sub = tid & 15;
            const int n = min((int)pr.ncand[q], DSA_CAP), k = pr.krem[q];
            LAS const float* cs = (LAS const float*)(L + L_H) + q * DSA_CAP; LAS const unsigned* ck = (LAS const unsigned*)(L + L_H + 32768) + q * DSA_CAP;
            LAS unsigned* sh = (LAS unsigned*)(L + L_H + 65536) + q * 256;
            LAS unsigned short* tie = (LAS unsigned short*)(L + L_SEL) + q * 256;
            LAS unsigned* bmq = (LAS unsigned*)(L + L_H + 98304) + q * 256;
            const float fs = (lvl1 ? pr.sc1[q] : pr.sc0[q]) * 256.f, fo = (lvl1 ? (pr.off1[q] - (float)pr.b1[q]) : (pr.off0[q] - (float)pr.b0[q])) * 256.f;
            { const u32x4 z4 = opaque_splat(0u);
#pragma unroll
            for (int i = 0; i < 4; ++i) *(LAS u32x4*)(sh + 16 * sub + 4 * i) = z4; }
            if (sub == 0) pr.cin[q] = 0;
            __syncthreads();
#pragma unroll 1
            for (int i = sub; i < n; i += 16) { int c = (int)__builtin_fmaf(cs[i], fs, fo); c = min(max(c, 0), 255); __hip_atomic_fetch_add(sh + c, 1u, __ATOMIC_RELAXED, __HIP_MEMORY_SCOPE_WORKGROUP); }
            __syncthreads();
            { int sacc = 0;
#pragma unroll
              for (int i = 0; i < 16; ++i) sacc += (int)sh[16 * sub + i];
              pr.part[q * 16 + sub] = sacc; }
            __syncthreads();
            if (sub == 0) { int acc = 0, c = 15;
#pragma unroll 1
                for (; c > 0; --c) { const int p = pr.part[q * 16 + c]; if (acc + p >= k) break; acc += p; }
                int j = 15;
#pragma unroll 1
                for (; j > 0; --j) { const int v = (int)sh[16 * c + j]; if (acc + v >= k) break; acc += v; }
                pr.b1[q] = 16 * c + j; pr.krem[q] = k - acc; }
            __syncthreads();
            const int b2 = pr.b1[q], k2 = pr.krem[q];
#pragma unroll 1
            for (int i = sub; i < n; i += 16) { int c = (int)__builtin_fmaf(cs[i], fs, fo); c = min(max(c, 0), 255);
                if (c > b2) { const unsigned ki = ck[i]; __hip_atomic_fetch_or(bmq + (ki >> 5), 1u << (ki & 31u), __ATOMIC_RELAXED, __HIP_MEMORY_SCOPE_WORKGROUP); }
                else if (c == b2) { const unsigned pos = __hip_atomic_fetch_add((LAS unsigned*)pr.cin + q, 1u, __ATOMIC_RELAXED, __HIP_MEMORY_SCOPE_WORKGROUP); tie[pos] = (unsigned short)i; } }
            __syncthreads();
            const int nt = pr.cin[q];
#pragma unroll 1
            for (int a = sub; a < nt; a += 16) { const int ia = tie[a]; const float si = cs[ia]; const unsigned ki = ck[ia]; int rank = 0;
#pragma unroll 1
                for (int bb = 0; bb < nt; ++bb) { const int ib = tie[bb]; const float sj = cs[ib]; const unsigned kj = ck[ib]; rank += (sj > si || (sj == si && kj < ki)) ? 1 : 0; }
                if (rank < k2) __hip_atomic_fetch_or(bmq + (ki >> 5), 1u << (ki & 31u), __ATOMIC_RELAXED, __HIP_MEMORY_SCOPE_WORKGROUP); }
        }
        }
        __syncthreads();
        { const u32x4 f4 = opaque_splat(0xFFFFFFFFu); for (int i = tid; i < 32 * 256 / 8; i += NTHREADS) ((LAS u32x4*)selall)[i] = f4; }
        __syncthreads();
        for (int rl_ = 0; rl_ < REP_LIST; ++rl_)
        {
            const int q = tid >> 4, sub = tid & 15;
            LAS const unsigned* bm = (LAS const unsigned*)(L + L_H + 98304) + q * 256 + sub * 16;
            int cnt = 0; unsigned bw[16];
            { u32x4 b4[4];
#pragma unroll
              for (int i = 0; i < 4; ++i) b4[i] = *(LAS const u32x4*)(bm + 4 * i);
#pragma unroll
              for (int i = 0; i < 16; ++i) { bw[i] = b4[i >> 2][i & 3]; cnt += __builtin_popcount(bw[i]); } }
            pr.part[q * 16 + sub] = cnt;
            __syncthreads();
            int off = 0;
#pragma unroll
            for (int i4 = 0; i4 < 4; ++i4) { const u32x4 p4 = *(LAS const u32x4*)(pr.part + q * 16 + 4 * i4);
                off += ((4 * i4 + 0 < sub) ? (int)p4.x : 0) + ((4 * i4 + 1 < sub) ? (int)p4.y : 0) + ((4 * i4 + 2 < sub) ? (int)p4.z : 0) + ((4 * i4 + 3 < sub) ? (int)p4.w : 0); }
            if (sub == 15) pr.nsel[q] = (unsigned)min(off + cnt, 256);
#pragma unroll
            for (int i = 0; i < 16; ++i) { unsigned w = bw[i];
#pragma unroll 1
                while (w) { const int bit = __builtin_ctz(w); w &= w - 1u; if (off < 256) selall[q * 256 + off] = (unsigned short)((sub * 16 + i) * 32 + bit); ++off; } }
        }
        __syncthreads();
        }
    }
    LAS const float* biasT = (LAS const float*)(L + L_BIAS);
    LAS unsigned char* vl = L + L_H + wid * (64 * DSA_VS);
    const int i16 = lane & 15, g4 = lane >> 4;
    const GAS bf16_t* Pg = (const GAS bf16_t*)Pb; const GAS bf16_t* Dg = (const GAS bf16_t*)DKVb;
    bf16x8 kalo[8][2];
#define DSA_LOADKA(dst, qq, kb0) do { LAS const unsigned short* sel_ = selall + (qq) * 256; \
        _Pragma("unroll") for (int kb_ = 0; kb_ < 8; ++kb_) { const int key_ = (int)sel_[16 * ((kb0) + kb_) + i16] & (SEQ - 1);     \
            const GAS bf16_t* kp_ = Dg + (size_t)key_ * 128 + 8 * g4; dst[kb_][0] = *(const GAS bf16x8*)kp_; dst[kb_][1] = *(const GAS bf16x8*)(kp_ + 32); } } while (0)
    DSA_LOADKA(kalo, wid * 4, 0);
    LAS unsigned char* qs = L + L_H + 81920 + wid * 2560;
    { u32x4 qv[3];
#pragma unroll
      for (int i = 0; i < 3; ++i) { const int c = min(lane + 64 * i, 159); qv[i] = *(const GAS u32x4*)(Pg + (size_t)(t0 + 4 * wid + c / 40) * NP + C_DQ + (c % 40) * 8); }
#pragma unroll
      for (int i = 0; i < 3; ++i) if (lane + 64 * i < 160) *(LAS u32x4*)(qs + (lane + 64 * i) * 16) = qv[i]; }
#pragma unroll 1
    for (int qi = 0; qi < 4; ++qi) {
        const int q = wid * 4 + qi, t = t0 + q;
        LAS const unsigned short* sel = selall + q * 256;
        bf16x8 qb0 = {}, qb1 = {};
        if (i16 < 5) { LAS const unsigned char* qp = qs + (qi * 40 + i16 * 8 + g4) * 16; qb0 = *(LAS const bf16x8*)qp; qb1 = *(LAS const bf16x8*)(qp + 64); }
        f32x4 sc[16];
        { bf16x8 kahi[8][2];
          DSA_LOADKA(kahi, q, 8);
          __builtin_amdgcn_sched_barrier(0);
#pragma unroll
          for (int kb = 0; kb < 8; ++kb) { f32x4 acc = {0.f, 0.f, 0.f, 0.f}; acc = mfma16(kalo[kb][0], qb0, acc); acc = mfma16(kalo[kb][1], qb1, acc); sc[kb] = acc; }
#pragma unroll
          for (int kb = 0; kb < 8; ++kb) { f32x4 acc = {0.f, 0.f, 0.f, 0.f}; acc = mfma16(kahi[kb][0], qb0, acc); acc = mfma16(kahi[kb][1], qb1, acc); sc[8 + kb] = acc; } }
        __builtin_amdgcn_sched_barrier(0);
        u32x4 vv[8];
#pragma unroll
        for (int i = 0; i < 8; ++i) { const int key = (int)sel[8 * i + (lane >> 3)] & (SEQ - 1); vv[i] = *(const GAS u32x4*)(Dg + (size_t)key * 128 + 64 + (lane & 7) * 8); }
        float mx = -1e30f;
        const float bfar = biasT[128 * 8 + (i16 & 7)];
        int klast[16];
#pragma unroll
        for (int kb = 0; kb < 16; ++kb) klast[kb] = (int)sel[16 * kb + 15];
        __builtin_amdgcn_sched_barrier(0);
#pragma unroll
        for (int kb = 0; kb < 16; ++kb) {
            if (klast[kb] + 128 <= t) {
#pragma unroll
                for (int r = 0; r < 4; ++r) { const float sv = sc[kb][r] + bfar; sc[kb][r] = sv; mx = fmaxf(mx, sv); }
            } else {
                const u32x2 sk = *(LAS const u32x2*)(sel + 16 * kb + 4 * g4);
                const int keys[4] = {(int)(sk.x & 0xffffu), (int)(sk.x >> 16), (int)(sk.y & 0xffffu), (int)(sk.y >> 16)};
                float bv[4];
#pragma unroll
                for (int r = 0; r < 4; ++r) bv[r] = biasT[min(max(t - keys[r], 0), 128) * 8 + (i16 & 7)];
#pragma unroll
                for (int r = 0; r < 4; ++r) { float sv = sc[kb][r] + bv[r];
                    sv = (keys[r] == 0xFFFF) ? -1e30f : sv;
                    sc[kb][r] = sv; mx = fmaxf(mx, sv); }
            } }
        mx = fmaxf(mx, __shfl_xor(mx, 16)); mx = fmaxf(mx, __shfl_xor(mx, 32));
        float sum = 0.f;
#pragma unroll
        for (int kb = 0; kb < 16; ++kb)
#pragma unroll
            for (int r = 0; r < 4; ++r) { const float p = __builtin_amdgcn_exp2f(sc[kb][r] - mx); sc[kb][r] = p; sum += p; }
        sum += __shfl_xor(sum, 16); sum += __shfl_xor(sum, 32);
        const float inv = 1.f / sum;
        bf16x8 pa[8];
#pragma unroll
        for (int j = 0; j < 8; ++j) pa[j] = pack8(sc[2 * j][0] * inv, sc[2 * j][1] * inv, sc[2 * j][2] * inv, sc[2 * j][3] * inv, sc[2 * j + 1][0] * inv, sc[2 * j + 1][1] * inv, sc[2 * j + 1][2] * inv, sc[2 * j + 1][3] * inv);
        __builtin_amdgcn_sched_barrier(0);
        if (qi < 3) DSA_LOADKA(kalo, q + 1, 0);
        __builtin_amdgcn_sched_barrier(0);
        f32x4 o[4] = {{0.f, 0.f, 0.f, 0.f}, {0.f, 0.f, 0.f, 0.f}, {0.f, 0.f, 0.f, 0.f}, {0.f, 0.f, 0.f, 0.f}};
#pragma unroll
        for (int c = 0; c < 4; ++c) {
#pragma unroll
            for (int i = 0; i < 8; ++i) { const int row = 8 * i + (lane >> 3), ch = lane & 7; *(LAS u32x4*)(vl + row * DSA_VS + ch * 16) = vv[i]; }
            if (c + 1 < 4) {
#pragma unroll
                for (int i = 0; i < 8; ++i) { const int key = (int)sel[64 * (c + 1) + 8 * i + (lane >> 3)] & (SEQ - 1); vv[i] = *(const GAS u32x4*)(Dg + (size_t)key * 128 + 64 + (lane & 7) * 8); }
            }
            asm volatile("s_waitcnt lgkmcnt(0)" ::: "memory");
#pragma unroll
            for (int s2 = 0; s2 < 2; ++s2) {
                LAS const unsigned char* vp = vl + (32 * s2 + 4 * g4 + (i16 >> 2)) * DSA_VS + (4 * (i16 & 3)) * 2;
#pragma unroll
                for (int nb = 0; nb < 4; ++nb) { const bf16x8 vb = cat8(ldtr(vp + nb * 32), ldtr(vp + 16 * DSA_VS + nb * 32)); o[nb] = mfma16(pa[2 * c + s2], vb, o[nb]); }
            }
            asm volatile("s_waitcnt lgkmcnt(0)" ::: "memory");
        }
        bf16_t* orow = MIX + (rowbase + t) * D + 384;
#pragma unroll
        for (int nb = 0; nb < 4; ++nb)
#pragma unroll
            for (int r = 0; r < 4; ++r) { const int head = 4 * g4 + r; if (head < 5) { const unsigned pk = pk_bf16(o[nb][r], 0.f); orow[head * 64 + 16 * nb + i16] = (bf16_t)(pk & 0xffffu); } }
    }
#undef DSA_LOADKA
    __syncthreads();
}

struct Args { const float* in[18]; float* out; unsigned char* ws; };
constexpr int N_MLA = NBATCH * 6 * 32, N_DSA = NBATCH * 256, N_SB = NBATCH * 32 * 5, N_ATT = N_MLA + N_DSA + N_SB;

#define CAS __attribute__((address_space(4)))
#define KARGS(k) const CAS Args* k = (const CAS Args*)__builtin_amdgcn_kernarg_segment_ptr(); asm volatile("" : "+s"(k))
constexpr int CI_IN = 16 * 88, CI_UQ = 6 * 24, CI_UKV = 4 * 24, CI_O = 16 * 32, CI_GU = 16 * 176, CI_DN = 44 * 32, CI_PG = 16 * 32, CI_PP = 4 * 32;
constexpr int CONV_ITEMS = CI_IN + CI_UQ + CI_UKV + CI_O + CI_GU + CI_DN + CI_PG + CI_PP;
constexpr int CONV_PER_UNIT = 16, N_CONVU = (CONV_ITEMS + CONV_PER_UNIT - 1) / CONV_PER_UNIT;
__device__ __forceinline__ void conv_layer_item(const CAS Args* ka, int ly, int r, LAS float* scr) {
    unsigned char* wl = ka->ws + WS_W + (size_t)ly * LAYER_W_BYTES;
    if (r < CI_IN) { MapIn mp{ka->in[2] + (size_t)ly * D * DIN}; conv_item(mp, 1024, (bf16_t*)(wl + W_IN), scr, r, 88, ka->in[3] + ly * D); return; } r -= CI_IN;
    if (r < CI_UQ) { MapUq mp{ka->in[5] + (size_t)ly * 384 * 576}; conv_item(mp, 384, (bf16_t*)(wl + W_UQ), scr, r, 24, ka->in[4] + ly * 384); return; } r -= CI_UQ;
    if (r < CI_UKV) { MapUkv mp{ka->in[7] + (size_t)ly * 256 * 768}; conv_item(mp, 256, (bf16_t*)(wl + W_UKV), scr, r, 24, ka->in[6] + ly * 256); return; } r -= CI_UKV;
    if (r < CI_O) { MapId mp{ka->in[9] + (size_t)ly * D * D, D}; conv_item(mp, 1024, (bf16_t*)(wl + W_O), scr, r, 32); return; } r -= CI_O;
    if (r < CI_GU) { MapGu mp{ka->in[11] + (size_t)ly * D * DFF, ka->in[12] + (size_t)ly * D * DFF}; conv_item(mp, 1024, (bf16_t*)(wl + W_GU), scr, r, 176, ka->in[10] + ly * D); return; } r -= CI_GU;
    if (r < CI_DN) { MapId mp{ka->in[13] + (size_t)ly * DFF * D, D}; conv_item(mp, 2816, (bf16_t*)(wl + W_DN), scr, r, 32); return; } r -= CI_DN;
    if (r < CI_PG) { MapId mp{ka->in[15] + (size_t)ly * D * D, D}; conv_item(mp, 1024, (bf16_t*)(wl + W_PG), scr, r, 32, ka->in[14] + ly * D); return; } r -= CI_PG;
    { MapId mp{ka->in[16] + (size_t)ly * PLE * D, D}; conv_item(mp, 256, (bf16_t*)(wl + W_PP), scr, r, 32); }
}
__global__ void __launch_bounds__(NTHREADS, 2) mk_fwd(Args a_unused) {
    extern __shared__ __attribute__((aligned(16))) unsigned char lds_raw[];
    LAS unsigned char* L = (LAS unsigned char*)lds_raw;
    const int tid = threadIdx.x, lane = tid & 63, wid = __builtin_amdgcn_readfirstlane(tid >> 6);
    const int G = gridDim.x, bx = blockIdx.x;
    const int gw = bx * NWAVES + wid, ngw = G * NWAVES;
    volatile LAS unsigned* MISC = (volatile LAS unsigned*)(L + L_MISC);
    for (int u = tid; u < (LDS_BYTES - L_PRM) / 4; u += NTHREADS) ((LAS unsigned*)(L + L_PRM))[u] = 0u;
    {
        KARGS(ka);
        LAS float* biasT = (LAS float*)(L + L_BIAS);
        const float* rel_bias = ka->in[8];
        for (int i = tid; i < 129 * 8; i += NTHREADS) { const int d = i >> 3, h = i & 7; int bucket;
            if (d < 16) bucket = d; else { bucket = 16 + (int)(logf((float)d / 16.f) / logf(8.f) * 16.f); bucket = min(bucket, 31); }
            biasT[i] = (h < 5) ? rel_bias[bucket * 5 + h] * LOG2E : 0.f; }
    }
    __syncthreads();
    XcdBarrier bar;
    { KARGS(ka); bar = xcd_barrier_post((unsigned*)(ka->ws + WS_CTL) + CW_BAR, MISC); }

    {
        KARGS(ka);
        LAS float* scr = (LAS float*)(L + L_H + wid * 16384);
        for (int it = gw; it < CONV_ITEMS; it += ngw) conv_layer_item(ka, 0, it, scr);
    }
    { KARGS(ka); x_to_h_rows(ka->in[0], (bf16_t*)(ka->ws + WS_HA), (float*)(ka->ws + WS_SS + 2 * SS_BYTES), gw, ngw); }
    xcd_barrier(bar);

    for (int ly = 0; ly < DEPTH; ++ly) {
#define HCUR(ka) ((bf16_t*)((ly & 1) ? (unsigned char*)(ka)->out : (ka)->ws + WS_HA))
#define HNXT(ka) ((bf16_t*)((ly & 1) ? (ka)->ws + WS_HA : (unsigned char*)(ka)->out))
#define MIXB(ka) ((bf16_t*)((unsigned char*)(ka)->out + (size_t)M * D * 2))
#define SSP(ka, i) ((float*)((ka)->ws + WS_SS + (size_t)(i) * SS_BYTES))
        { KARGS(ka); unsigned char* ws = ka->ws; const unsigned char* wl = ws + WS_W + (size_t)ly * LAYER_W_BYTES;
          pg8::Gemm g{HCUR(ka), (const bf16_t*)(wl + W_IN), M, NP, 1024, 1024, 1024}; pg8::StaticOrder S; S.init(M, NP, G, bx);
          pg8::EpiInProj E{(bf16_t*)(ws + WS_P), SSP(ka, 2), (float*)(ws + WS_SSN), (bf16_t*)(ws + WS_KR), (bf16_t*)(ws + WS_IKC), (bf16_t*)(ws + WS_DKV), (unsigned*)(ws + WS_CTL) + CW_KMAX + 64 * 4 * ly};
          for (int rep = 0; rep < REP_GEMM; ++rep) pg8::gemm_phase(L + L_H, g, S, E);
          const int nfull = ((M / 256) * (NP / 256)) % G;
          if (nfull == 0) cvt_p_rows(ka->in[1] + (size_t)ly * M * PLE, (bf16_t*)(ws + WS_PB), bx * NTHREADS, G * NTHREADS);
          else if (bx >= nfull) cvt_p_rows(ka->in[1] + (size_t)ly * M * PLE, (bf16_t*)(ws + WS_PB), (bx - nfull) * NTHREADS, (G - nfull) * NTHREADS); }
        xcd_barrier(bar);
        { KARGS(ka); unsigned char* ws = ka->ws; const unsigned char* wl = ws + WS_W + (size_t)ly * LAYER_W_BYTES;
          pg8::Gemm g{(const bf16_t*)(ws + WS_P) + C_CQ, (const bf16_t*)(wl + W_UQ), M, 768, 384, NP, 384}; pg8::StaticOrder S; S.init(M, 768, G, bx);
          pg8::EpiUq E{(bf16_t*)(ws + WS_QM), (const float*)(ws + WS_SSN)}; pg8::gemm_phase(L + L_H, g, S, E); }
        { KARGS(ka); unsigned char* ws = ka->ws; const unsigned char* wl = ws + WS_W + (size_t)ly * LAYER_W_BYTES;
          pg8::Gemm g{(const bf16_t*)(ws + WS_P) + C_CKV, (const bf16_t*)(wl + W_UKV), M, 768, 256, NP, 256}; pg8::StaticOrder S; S.init(M, 768, G, (bx + G / 2) % G);
          pg8::EpiBf16 E{(bf16_t*)(ws + WS_KV), KV_LD, KV_LD, (const float*)(ws + WS_SSN), 2}; pg8::gemm_phase(L + L_H, g, S, E); }
        xcd_barrier(bar);
        {
            bool first_unit = true;
            for (;;) {
                KARGS(ka); unsigned char* ws = ka->ws;
                int u;
                if (first_unit) { u = bx; first_unit = false; }
                else {
                    if (tid == 0) MISC[4] = atomicAdd((unsigned*)(ws + WS_CTL) + CW_Q + 64 * ly, 1u) + (unsigned)G;
                    __syncthreads();
                    u = (int)MISC[4];
                    __syncthreads(); }
                if (u >= N_ATT + ((ly + 1 < DEPTH) ? N_CONVU : 0)) break;
                if (u >= N_ATT) {
                    LAS float* scr = (LAS float*)(L + L_H + wid * 16384);
                    for (int j = 0; j < CONV_PER_UNIT / NWAVES; ++j) { const int it = (u - N_ATT) * CONV_PER_UNIT + j * NWAVES + wid; if (it < CONV_ITEMS) conv_layer_item(ka, ly + 1, it, scr); }
                    __syncthreads();
                }
                else if (u < N_MLA) { const int qt = 31 - u / 24, bh = u % 24; for (int rep = 0; rep < REP_MLA; ++rep) mla_unit(L + L_H, (const bf16_t*)(ws + WS_QM), (const bf16_t*)(ws + WS_KV), (const bf16_t*)(ws + WS_KR), MIXB(ka), bh / 6, bh % 6, qt); }
                else if (u < N_MLA + N_DSA) { const int v = u - N_MLA; for (int rep = 0; rep < REP_DSA; ++rep) dsa_unit(L, (const bf16_t*)(ws + WS_P), (const bf16_t*)(ws + WS_IKC), (const bf16_t*)(ws + WS_DKV), MIXB(ka), (const unsigned*)(ws + WS_CTL) + CW_KMAX + 64 * 4 * ly, v & 3, 255 - (v >> 2)); }
                else { const int v = u - N_MLA - N_DSA; const int h = v % 5, r = v / 5; for (int rep = 0; rep < REP_SB; ++rep) { sb_unit(L + L_H, (const bf16_t*)(ws + WS_P), MIXB(ka), r & 3, r >> 2, h); __syncthreads(); } }
            }
        }
        xcd_barrier(bar);
        { KARGS(ka); unsigned char* ws = ka->ws; const unsigned char* wl = ws + WS_W + (size_t)ly * LAYER_W_BYTES;
          pg8::Gemm g{MIXB(ka), (const bf16_t*)(wl + W_O), M, D, 1024, 1024, 1024}; pg8::StaticOrder S; S.init(M, D, G, bx);
          pg8::EpiResid E{HCUR(ka), SSP(ka, 0)}; pg8::gemm_phase(L + L_H, g, S, E); }
        xcd_barrier(bar);
        { KARGS(ka); unsigned char* ws = ka->ws; const unsigned char* wl = ws + WS_W + (size_t)ly * LAYER_W_BYTES;
          pg8::Gemm g{HCUR(ka), (const bf16_t*)(wl + W_GU), M, 2 * DFF, 1024, 1024, 1024}; pg8::StaticOrder S; S.init(M, 2 * DFF, G, bx);
          pg8::EpiSwiglu E{(bf16_t*)(ws + WS_ACT), SSP(ka, 0)}; for (int rep = 0; rep < REP_GEMM; ++rep) pg8::gemm_phase(L + L_H, g, S, E); }
        { KARGS(ka); unsigned char* ws = ka->ws; const unsigned char* wl = ws + WS_W + (size_t)ly * LAYER_W_BYTES;
          pg8::Gemm g{(const bf16_t*)(ws + WS_PB), (const bf16_t*)(wl + W_PP), M, D, 256, 256, 256}; pg8::StaticOrder S; S.init(M, D, G, bx);
          pg8::EpiBf16 E{(bf16_t*)(ws + WS_PP), D, D, nullptr, 0}; pg8::gemm_phase(L + L_H, g, S, E); }
        xcd_barrier(bar);
        { KARGS(ka); unsigned char* ws = ka->ws; const unsigned char* wl = ws + WS_W + (size_t)ly * LAYER_W_BYTES;
          pg8::Gemm g{(const bf16_t*)(ws + WS_ACT), (const bf16_t*)(wl + W_DN), M, D, DFF, DFF, DFF}; pg8::StaticOrder S; S.init(M, D, G, bx);
          pg8::EpiResid E{HCUR(ka), SSP(ka, 1)}; pg8::gemm_phase(L + L_H, g, S, E); }
        xcd_barrier(bar);
        { KARGS(ka); unsigned char* ws = ka->ws; const unsigned char* wl = ws + WS_W + (size_t)ly * LAYER_W_BYTES;
          pg8::Gemm g{HCUR(ka), (const bf16_t*)(wl + W_PG), M, D, 1024, 1024, 1024}; pg8::StaticOrder S; S.init(M, D, G, bx);
          pg8::EpiPle E{HCUR(ka), HNXT(ka), (const bf16_t*)(ws + WS_PP), SSP(ka, 1), SSP(ka, 2)}; pg8::gemm_phase(L + L_H, g, S, E); }
        xcd_barrier(bar);
    }
    { KARGS(ka); final_norm_rows((const bf16_t*)(ka->ws + WS_HA), ka->in[17], ka->out, gw, ngw); }
}

extern "C" void kernel_launch(void* const* d_in, const int* in_sizes, int n_in, void* d_out, int out_size, void* d_ws, size_t ws_size, hipStream_t stream) {
    static int grid = 0;
    if (grid == 0) {
        if (n_in != 18 || out_size != M * D || ws_size < WS_END) { fprintf(stderr, "kernel_launch: unexpected shapes (n_in %d, out %d, ws %zu); nothing launched\n", n_in, out_size, ws_size); grid = -1; return; }
        int dev = 0, cus = 0, per_cu = 0;
        if (hipGetDevice(&dev) != hipSuccess || hipDeviceGetAttribute(&cus, hipDeviceAttributeMultiprocessorCount, dev) != hipSuccess) { grid = -1; return; }
        if (hipFuncSetAttribute((const void*)mk_fwd, hipFuncAttributeMaxDynamicSharedMemorySize, LDS_BYTES) != hipSuccess) { fprintf(stderr, "kernel_launch: hipFuncSetAttribute failed\n"); grid = -1; return; }
        if (hipOccupancyMaxActiveBlocksPerMultiprocessor(&per_cu, (const void*)mk_fwd, NTHREADS, LDS_BYTES) != hipSuccess || per_cu < 1) { fprintf(stderr, "kernel_launch: occupancy query says %d\n", per_cu); }
        (void)hipGetLastError();
        grid = cus;
    }
    if (grid < 0) return;
    if (hipMemsetAsync((char*)d_ws + WS_CTL, 0, CTL_ZERO_BYTES, stream) != hipSuccess) return;
    Args a{};
    for (int i = 0; i < 18; ++i) a.in[i] = (const float*)d_in[i];
    a.out = (float*)d_out; a.ws = (unsigned char*)d_ws;
    hipLaunchKernelGGL(mk_fwd, dim3(grid), dim3(NTHREADS), LDS_BYTES, stream, a);
}
```
